# Optimizing an MI355X kernel written in HIP

```python
import math
import jax, jax.numpy as jnp
from jax import lax
import numpy as np

D_MODEL = 1024
BATCH = 16
SEQ = 2048
DEPTH = 2

N_EVEN = (DEPTH + 1) // 2
N_ODD = DEPTH // 2
HEAD_DIM = 64
ATT_HEADS = 8
ATT_WIDTH = ATT_HEADS * HEAD_DIM
DILATED_BRANCHES = ((128, 1), (512, 4), (2048, 16))
ATT_QBLOCK = 64
ROPE_THETA = 10000.0
SGU_GROUPS = 8
SGU_DIM = 64
SGU_WIDTH = SGU_GROUPS * SGU_DIM
SGU_CHUNK = 128
IN_WIDTH = 3 * ATT_WIDTH + 2 * SGU_WIDTH
MIX_WIDTH = ATT_WIDTH + SGU_WIDTH
S5_GROUP = 16
S5_GROUPS = D_MODEL // S5_GROUP
S5_STATE = 64
PEER_HEADS = 8
PEER_QDIM = 256
PEER_HALF = PEER_QDIM // 2
PEER_NKEYS = 128
PEER_EXPERTS = PEER_NKEYS * PEER_NKEYS
PEER_TOPK = 16
PEER_TBLOCK = 128
RMS_EPS = 1e-6
LN_EPS = 1e-5

kernel_name = 'hybrid_dilated_sgu_s5_peer'


def rmsnorm(x, g):
    xf = x.astype(jnp.float32)
    y = xf * lax.rsqrt(jnp.mean(xf * xf, axis=-1, keepdims=True) + RMS_EPS)
    return (y * g.astype(jnp.float32)).astype(x.dtype)


def rotary(x, pos):
    half = HEAD_DIM // 2
    inv = jnp.power(ROPE_THETA, -2.0 * jnp.arange(half, dtype=jnp.float32) / HEAD_DIM)
    ang = pos[:, None] * inv[None, :]
    cos = jnp.cos(ang)[None, :, None, :]
    sin = jnp.sin(ang)[None, :, None, :]
    xf = x.astype(jnp.float32)
    x1, x2 = xf[..., :half], xf[..., half:]
    return jnp.concatenate([x1 * cos - x2 * sin, x2 * cos + x1 * sin], axis=-1).astype(x.dtype)


def dilated_attention(q, k, v):
    b, h, s, hd = q.shape
    n_blk = s // ATT_QBLOCK
    scale = HEAD_DIM ** -0.5

    def block(i):
        start = i * ATT_QBLOCK
        qb = lax.dynamic_slice_in_dim(q, start, ATT_QBLOCK, axis=2)
        t = start + jnp.arange(ATT_QBLOCK)
        outs, lses = [], []
        for window, dil in DILATED_BRANCHES:
            steps = jnp.arange(window // dil + 1)
            pos = t[:, None] - dil * steps[None, :]
            valid = pos >= 0
            pos = jnp.maximum(pos, 0)
            kg = k[:, :, pos]
            vg = v[:, :, pos]
            sc = jnp.einsum('bhqd,bhqld->bhql', qb, kg, preferred_element_type=jnp.float32) * scale
            sc = jnp.where(valid, sc, -jnp.inf)
            m = jnp.max(sc, axis=-1)
            p = jnp.exp(sc - m[..., None])
            den = jnp.sum(p, axis=-1)
            outs.append(jnp.einsum('bhql,bhqld->bhqd', p, vg.astype(jnp.float32)) / den[..., None])
            lses.append(m + jnp.log(den))
        w = jax.nn.softmax(jnp.stack(lses), axis=0)
        return jnp.einsum('rbhq,rbhqd->bhqd', w, jnp.stack(outs))

    out = lax.map(block, jnp.arange(n_blk))
    return out.transpose(1, 0, 3, 2, 4).reshape(b, s, h * hd)


def hybrid_ab(h, w_in, sgu_norm_g, sgu_w, sgu_b, w_out):
    b, s, _ = h.shape
    z = h @ w_in
    q, k, v, zb = jnp.split(z, [ATT_WIDTH, 2 * ATT_WIDTH, 3 * ATT_WIDTH], axis=-1)
    pos = jnp.arange(s, dtype=jnp.float32)
    q = rotary(q.reshape(b, s, ATT_HEADS, HEAD_DIM), pos).transpose(0, 2, 1, 3)
    k = rotary(k.reshape(b, s, ATT_HEADS, HEAD_DIM), pos).transpose(0, 2, 1, 3)
    v = v.reshape(b, s, ATT_HEADS, HEAD_DIM).transpose(0, 2, 1, 3)
    att = dilated_attention(q, k, v).astype(h.dtype)
    zb = jax.nn.gelu(zb)
    u, g = jnp.split(zb, 2, axis=-1)
    gf = g.reshape(b, s, SGU_GROUPS, SGU_DIM).astype(jnp.float32)
    mu = jnp.mean(gf, axis=-1, keepdims=True)
    var = jnp.mean(jnp.square(gf - mu), axis=-1, keepdims=True)
    gf = (gf - mu) * lax.rsqrt(var + LN_EPS) * sgu_norm_g.astype(jnp.float32)
    gc = gf.reshape(b, s // SGU_CHUNK, SGU_CHUNK, SGU_GROUPS, SGU_DIM)
    w_causal = jnp.tril(sgu_w.astype(jnp.float32))
    sp = jnp.einsum('hij,bcjhd->bcihd', w_causal, gc) + sgu_b.astype(jnp.float32).T[:, :, None]
    sgu = (u.astype(jnp.float32) * sp.reshape(b, s, SGU_WIDTH)).astype(h.dtype)
    return jnp.concatenate([att, sgu], axis=-1) @ w_out


def s5_block(h, lam_re, lam_im, b_re, b_im, c_re, c_im, d_skip, log_step, glu_w, glu_b):
    b, s, _ = h.shape
    hf = h.astype(jnp.float32)
    u = hf.reshape(b, s, S5_GROUPS, S5_GROUP)
    dt = jnp.exp(log_step.astype(jnp.float32))[:, None]
    lr = lam_re.astype(jnp.float32)
    li = lam_im.astype(jnp.float32)
    decay = jnp.exp(lr * dt)
    ar = decay * jnp.cos(li * dt)
    ai = decay * jnp.sin(li * dt)
    mag = lr * lr + li * li
    kr = ((ar - 1.0) * lr + ai * li) / mag
    ki = (ai * lr - (ar - 1.0) * li) / mag
    br = b_re.astype(jnp.float32)
    bi = b_im.astype(jnp.float32)
    bbr = kr[..., None] * br - ki[..., None] * bi
    bbi = kr[..., None] * bi + ki[..., None] * br
    xr = jnp.einsum('bsgc,gpc->bsgp', u, bbr)
    xi = jnp.einsum('bsgc,gpc->bsgp', u, bbi)
    a_r = jnp.broadcast_to(ar, (1, s) + ar.shape)
    a_i = jnp.broadcast_to(ai, (1, s) + ai.shape)

    def combine(e1, e2):
        a1r, a1i, b1r, b1i = e1
        a2r, a2i, b2r, b2i = e2
        return (a2r * a1r - a2i * a1i, a2r * a1i + a2i * a1r,
                a2r * b1r - a2i * b1i + b2r, a2r * b1i + a2i * b1r + b2i)

    _, _, sr, si = lax.associative_scan(combine, (a_r, a_i, xr, xi), axis=1)
    y = (jnp.einsum('bsgp,gcp->bsgc', sr, c_re.astype(jnp.float32))
         - jnp.einsum('bsgp,gcp->bsgc', si, c_im.astype(jnp.float32)))
    y = y.reshape(b, s, D_MODEL) + d_skip.astype(jnp.float32) * hf
    g = jax.nn.gelu(y)
    out = g * jax.nn.sigmoid(g @ glu_w.astype(jnp.float32) + glu_b.astype(jnp.float32))
    return out.astype(h.dtype)


def peer(h, wq, subkeys, u_tab, v_tab):
    b, s, d = h.shape
    xt = h.reshape(-1, d)
    t = xt.shape[0]
    q = (xt @ wq).reshape(t, PEER_HEADS, 2, PEER_HALF)
    sc = jnp.einsum('thpc,pkc->thpk', q, subkeys, preferred_element_type=jnp.float32)
    sv, si = lax.top_k(sc, PEER_TOPK)
    cand = sv[:, :, 0, :, None] + sv[:, :, 1, None, :]
    cidx = si[:, :, 0, :, None] * PEER_NKEYS + si[:, :, 1, None, :]
    cs, cpos = lax.top_k(cand.reshape(t, PEER_HEADS, -1), PEER_TOPK)
    idx = jnp.take_along_axis(cidx.reshape(t, PEER_HEADS, -1), cpos, axis=-1)
    gate = jax.nn.softmax(cs, axis=-1)
    nb = t // PEER_TBLOCK
    idx = idx.reshape(nb, PEER_TBLOCK, PEER_HEADS * PEER_TOPK)
    gate = gate.reshape(nb, PEER_TBLOCK, PEER_HEADS * PEER_TOPK)
    xb = xt.reshape(nb, PEER_TBLOCK, d)

    def expert_block(args):
        xbb, ib, gb = args
        act = jax.nn.gelu(jnp.einsum('td,tkd->tk', xbb, u_tab[ib], preferred_element_type=jnp.float32))
        return jnp.einsum('tk,tkd->td', gb * act, v_tab[ib].astype(jnp.float32))

    y = lax.map(expert_block, (xb, idx, gate))
    return y.reshape(b, s, d).astype(h.dtype)


def setup_inputs(seed: int = 0) -> dict:
    key = jax.random.key(seed)
    ks = iter(jax.random.split(key, 32))

    def nrm(shape, scale):
        return scale * jax.random.normal(next(ks), shape, jnp.float32)

    n = jnp.arange(S5_STATE, dtype=jnp.float32)
    return {
        'x': nrm((BATCH, SEQ, D_MODEL), 1.0),
        'norm_mix_g': 1.0 + nrm((DEPTH, D_MODEL), 0.02),
        'norm_ffn_g': 1.0 + nrm((DEPTH, D_MODEL), 0.02),
        'final_norm_g': 1.0 + nrm((D_MODEL,), 0.02),
        'mix_w_in': nrm((N_EVEN, D_MODEL, IN_WIDTH), D_MODEL ** -0.5),
        'sgu_norm_g': 1.0 + nrm((N_EVEN, SGU_GROUPS, SGU_DIM), 0.02),
        'sgu_w': nrm((N_EVEN, SGU_GROUPS, SGU_CHUNK, SGU_CHUNK), SGU_CHUNK ** -0.5),
        'sgu_b': 1.0 + nrm((N_EVEN, SGU_GROUPS, SGU_CHUNK), 0.02),
        'mix_w_out': nrm((N_EVEN, MIX_WIDTH, D_MODEL), MIX_WIDTH ** -0.5),
        's5_lambda_re': -0.5 + nrm((N_ODD, S5_GROUPS, S5_STATE), 0.01),
        's5_lambda_im': math.pi * n + nrm((N_ODD, S5_GROUPS, S5_STATE), 0.01),
        's5_b_re': nrm((N_ODD, S5_GROUPS, S5_STATE, S5_GROUP), (2 * S5_GROUP) ** -0.5),
        's5_b_im': nrm((N_ODD, S5_GROUPS, S5_STATE, S5_GROUP), (2 * S5_GROUP) ** -0.5),
        's5_c_re': nrm((N_ODD, S5_GROUPS, S5_GROUP, S5_STATE), S5_STATE ** -0.5),
        's5_c_im': nrm((N_ODD, S5_GROUPS, S5_GROUP, S5_STATE), S5_STATE ** -0.5),
        's5_d': nrm((N_ODD, D_MODEL), 1.0),
        's5_log_step': jax.random.uniform(next(ks), (N_ODD, S5_GROUPS), jnp.float32,
                                          minval=math.log(1e-3), maxval=math.log(1e-1)),
        'glu_w': nrm((N_ODD, D_MODEL, D_MODEL), D_MODEL ** -0.5),
        'glu_b': nrm((N_ODD, D_MODEL), 0.01),
        'peer_wq': nrm((DEPTH, D_MODEL, PEER_HEADS * PEER_QDIM), D_MODEL ** -0.5),
        'peer_subkeys': nrm((DEPTH, 2, PEER_NKEYS, PEER_HALF), PEER_HALF ** -0.5),
        'peer_u': nrm((DEPTH, PEER_EXPERTS, D_MODEL), D_MODEL ** -0.5),
        'peer_v': nrm((DEPTH, PEER_EXPERTS, D_MODEL), PEER_HEADS ** -0.5),
    }


def reference(x, norm_mix_g, norm_ffn_g, final_norm_g, mix_w_in, sgu_norm_g, sgu_w, sgu_b,
              mix_w_out, s5_lambda_re, s5_lambda_im, s5_b_re, s5_b_im, s5_c_re, s5_c_im,
              s5_d, s5_log_step, glu_w, glu_b, peer_wq, peer_subkeys, peer_u, peer_v):
    for layer in range(DEPTH):
        j = layer // 2
        h = rmsnorm(x, norm_mix_g[layer])
        if layer % 2 == 0:
            x = x + hybrid_ab(h, mix_w_in[j], sgu_norm_g[j], sgu_w[j], sgu_b[j], mix_w_out[j])
        else:
            x = x + s5_block(h, s5_lambda_re[j], s5_lambda_im[j], s5_b_re[j], s5_b_im[j],
                             s5_c_re[j], s5_c_im[j], s5_d[j], s5_log_step[j], glu_w[j], glu_b[j])
        h = rmsnorm(x, norm_ffn_g[layer])
        x = x + peer(h, peer_wq[layer], peer_subkeys[layer], peer_u[layer], peer_v[layer])
    return rmsnorm(x, final_norm_g)
```

```cpp
#include <hip/hip_runtime.h>
#include <hip/hip_cooperative_groups.h>
#include <cstdint>
#include <cstdio>
namespace cg = cooperative_groups;
#define PROBE_REP_PH -1
#define PROBE_REP_N 0
#define PROBE_S5_MODE 0
#define PROBE_REPLAY_K -1
#define XB_TMO      128
#define XB_XCNT(j)  (256  + 64 * (j))
#define XB_XSUB(j)  (1280 + 64 * (j))
#define XB_XGEN(j)  (2304 + 64 * (j))
#define XB_TOP      3328
#define XB_TOPGEN   3392
#define XCD_BAR_WORDS 3456
#define XB_SPIN_CAP (1u << 18)
#define LAS __attribute__((address_space(3)))

__device__ __forceinline__ unsigned xb_ld(unsigned* p)              { return __hip_atomic_load(p, __ATOMIC_RELAXED, __HIP_MEMORY_SCOPE_AGENT); }
__device__ __forceinline__ unsigned xb_add(unsigned* p, unsigned v) { return __hip_atomic_fetch_add(p, v, __ATOMIC_RELAXED, __HIP_MEMORY_SCOPE_AGENT); }
__device__ __forceinline__ unsigned xb_xcc_id() { return (unsigned)__builtin_amdgcn_s_getreg((3 << 11) | 20) & 0xFu; }
#define XB_SPIN(cond, bar) do { unsigned _sp = 0; while (cond) { __builtin_amdgcn_s_sleep(1); \
    if ((++_sp & 255u) == 0u) { if (xb_ld(&(bar)[XB_TMO])) break; if (_sp > XB_SPIN_CAP) { atomicAdd(&(bar)[XB_TMO], 1u); break; } } } } while (0)

struct XcdBarrier {
    unsigned* bar; unsigned x;
    volatile LAS unsigned* st;
};

__device__ __forceinline__ XcdBarrier xcd_barrier_post(unsigned* bar, volatile LAS unsigned* st) {
    XcdBarrier b; b.bar = bar; b.x = xb_xcc_id(); b.st = st;
    if (threadIdx.x == 0) (void)xb_add(&bar[XB_XCNT(b.x)], 1u);
    return b;
}
__device__ __forceinline__ void xcd_barrier_complete(unsigned* bar, unsigned x, unsigned& nloc, unsigned& nx) {
    const unsigned G = gridDim.x * gridDim.y * gridDim.z;
    unsigned sum, cnt, mine, sp = 0u;
    for (;;) {
        sum = 0u; cnt = 0u; mine = 0u;
#pragma unroll
        for (unsigned j = 0; j < 16; ++j) { const unsigned c = xb_ld(&bar[XB_XCNT(j)]); sum += c; cnt += (c > 0u) ? 1u : 0u; mine = (j == x) ? c : mine; }
        if (sum == G) break;
        __builtin_amdgcn_s_sleep(1);
        if ((++sp & 255u) == 0u) { if (xb_ld(&bar[XB_TMO])) break; if (sp > XB_SPIN_CAP) { atomicAdd(&bar[XB_TMO], 1u); break; } }
    }
    nloc = mine > 0u ? mine : 1u; nx = cnt > 0u ? cnt : 1u;
}

__device__ __forceinline__ void xcd_barrier(const XcdBarrier& b) {
    asm volatile("s_waitcnt vmcnt(0)" ::: "memory");
    __syncthreads();
    if (threadIdx.x == 0) {
        unsigned* bar = b.bar;
        __builtin_amdgcn_s_waitcnt(0);
        unsigned nloc = b.st[0], nx = b.st[1];
        if (nloc == 0u) { xcd_barrier_complete(bar, b.x, nloc, nx); b.st[0] = nloc; b.st[1] = nx; }
        const unsigned old = xb_add(&bar[XB_XSUB(b.x)], 1u);
        const unsigned gen = old / nloc;
        if (old + 1u == (gen + 1u) * nloc) {
            __builtin_amdgcn_fence(__ATOMIC_RELEASE, "agent");
            asm volatile("s_waitcnt vmcnt(0)" ::: "memory");
            const unsigned og = xb_add(&bar[XB_TOP], 1u);
            const unsigned tg = og / nx;
            if (og + 1u == (tg + 1u) * nx) xb_add(&bar[XB_TOPGEN], 1u);
            else XB_SPIN(xb_ld(&bar[XB_TOPGEN]) == tg, bar);
            __builtin_amdgcn_fence(__ATOMIC_ACQUIRE, "agent");
            xb_add(&bar[XB_XGEN(b.x)], 1u);
            asm volatile("s_waitcnt vmcnt(0)" ::: "memory");
        } else {
            XB_SPIN(xb_ld(&bar[XB_XGEN(b.x)]) == gen, bar);
            __builtin_amdgcn_fence(__ATOMIC_ACQUIRE, "agent");
            asm volatile("s_waitcnt vmcnt(0)" ::: "memory");
        }
    }
    __syncthreads();
}

namespace pg8 {
#define PG8_LAS __attribute__((address_space(3)))
typedef unsigned short bf16_t;
typedef short bf16x8 __attribute__((ext_vector_type(8)));
typedef float f32x4 __attribute__((ext_vector_type(4)));
typedef unsigned u32x4 __attribute__((ext_vector_type(4)));
constexpr int BM = 256, BK = 64, HALF = 128, HTB = HALF * BK * 2  , STAGE_BYTES = 8 * HTB, NXCD = 8, WGM = 8;

__host__ __device__ __forceinline__ int lds_byte(int r, int c) { const int st = (r >> 4) * 2 + (c >> 5), rr = r & 15, cc = c & 31, ob = rr * 64 + cc * 2; return st * 1024 + (ob ^ (((ob >> 9) & 1) << 5)); }
__host__ __device__ __forceinline__ void stage_rc(int b, int& R, int& C) { const int st = b / 1024, sb = b % 1024, swz = sb ^ (((sb >> 9) & 1) << 5); R = (st >> 1) * 16 + swz / 64; C = (st & 1) * 32 + (swz % 64) / 2; }
__host__ __device__ __forceinline__ int perm32(int rho) { const int n = rho >> 4, i = rho & 15; return 8 * (i >> 2) + 4 * n + (i & 3); }

struct Unit { int pm, pn; };
struct Gemm { const bf16_t* A; const bf16_t* Bt; int M, N, K; };

struct StaticOrder {
    int nM, nN, nwg, G, c;
    __host__ __device__ void init(int M, int N, int G_, int c_) { nM = M / BM; nN = N / BM; nwg = nM * nN; G = G_; c = c_; }
    __host__ __device__ bool next(int i, Unit& u) const {
        const long L = (long)i * G + c; if (L >= nwg) return false;
        int wgid = (int)L; { const int q = nwg / NXCD, r = nwg % NXCD, xcd = wgid % NXCD, off = wgid / NXCD; wgid = (xcd < r ? xcd * (q + 1) : r * (q + 1) + (xcd - r) * q) + off; }
        const int nig = WGM * nN, gid = wgid / nig, fm = gid * WGM, gsz = (nM - fm) < WGM ? (nM - fm) : WGM;
        u.pm = fm + ((wgid % nig) % gsz); u.pn = (wgid % nig) / gsz; return true;
    }
    __device__ __forceinline__ void a_ready(const Unit&) const {}
    __device__ __forceinline__ void done(const Unit&) const {}
};

template <class Epi, class Sched, bool ALIGN_EPI = false, bool SP2 = false>
__device__ __forceinline__ void gemm_phase(PG8_LAS unsigned char* lds, const Gemm g, const Sched& S, const Epi& E) {
    int tid_ = threadIdx.x; asm volatile("" : "+v"(tid_));
    const int tid = tid_, wid = __builtin_amdgcn_readfirstlane(tid >> 6), lane = tid & 63, wr = wid >> 2, wc = wid & 3, fr = lane & 15, fq = lane >> 4;
    const int K = g.K, nt = K / BK;
    unsigned voffA[2], voffB[2];
#pragma unroll
    for (int i = 0; i < 2; ++i) { int R, C; stage_rc(tid * 16 + i * 8192, R, C); const int Rb = Epi::PERM ? ((R & ~31) + perm32(R & 31)) : R;
        voffA[i] = (unsigned)(R * K + C) * 2u; voffB[i] = (unsigned)(Rb * K + C) * 2u; }
    const size_t kstep = (size_t)(BK * 2);
    const size_t hstep = (size_t)HALF * K * 2;
    const size_t tstep = 2 * hstep;
    const unsigned ldsw = (unsigned)wid * 1024u;
    const int aoff = lds_byte(wr * 64 + fr, fq * 8), boff = lds_byte(wc * 32 + fr, fq * 8);
#define PG8_SA(b, h) (((b) * 2 + (h)) * HTB)
#define PG8_SB(b, h) ((4 + (b) * 2 + (h)) * HTB)
#define PG8_STAGE(bufoff, gbase, voff) do { _Pragma("unroll") for (int _i = 0; _i < 2; ++_i) \
        __builtin_amdgcn_global_load_lds((const unsigned*)((const char*)(gbase) + (voff)[_i]), (PG8_LAS unsigned*)(lds + (bufoff) + ldsw + _i * 8192), 16, 0, 0); } while (0)
#define PG8_LDA(dst, b, h) do { _Pragma("unroll") for (int m = 0; m < 4; ++m) _Pragma("unroll") for (int k = 0; k < 2; ++k) dst[m][k] = *(const PG8_LAS bf16x8*)(lds + PG8_SA(b, h) + aoff + m * 2048 + k * 1024); } while (0)
#define PG8_LDB(dst, b, h) do { _Pragma("unroll") for (int n = 0; n < 2; ++n) _Pragma("unroll") for (int k = 0; k < 2; ++k) dst[n][k] = *(const PG8_LAS bf16x8*)(lds + PG8_SB(b, h) + boff + n * 2048 + k * 1024); } while (0)
#define PG8_MMA(ai, bj, At, Bt) do { __builtin_amdgcn_s_setprio(1); _Pragma("unroll") for (int m = 0; m < 4; ++m) _Pragma("unroll") for (int n = 0; n < 2; ++n) _Pragma("unroll") for (int k = 0; k < 2; ++k) \
        acc[ai][bj][m][n] = __builtin_amdgcn_mfma_f32_16x16x32_bf16(Bt[n][k], At[m][k], acc[ai][bj][m][n], 0, 0, 0); __builtin_amdgcn_s_setprio(0); } while (0)
#define PG8_WAIT_V(n) asm volatile("s_waitcnt vmcnt(" #n ")" ::: "memory")
#define PG8_WAIT_L(n) asm volatile("s_waitcnt lgkmcnt(" #n ")" ::: "memory")
#define PG8_BAR __builtin_amdgcn_s_barrier()
#define PG8_SCHED __builtin_amdgcn_sched_barrier(0)
    Unit cur, nxt; int ui = 0;
    if (!S.next(0, cur)) return;
    f32x4 acc[2][2][4][2];
#pragma unroll
    for (int a = 0; a < 2; ++a)
#pragma unroll
        for (int b = 0; b < 2; ++b)
#pragma unroll
            for (int m = 0; m < 4; ++m)
#pragma unroll
                for (int n = 0; n < 2; ++n) acc[a][b][m][n] = (f32x4){0.f, 0.f, 0.f, 0.f};
    bf16x8 At[4][2], B0[2][2], B1[2][2];
    const char* cA = (const char*)g.A + (size_t)cur.pm * tstep; const char* cB = (const char*)g.Bt + (size_t)cur.pn * tstep;
    S.a_ready(cur);
    if constexpr (SP2) {
        PG8_STAGE(PG8_SB(0, 0), cB, voffB); PG8_STAGE(PG8_SB(0, 1), cB + hstep, voffB); PG8_STAGE(PG8_SA(0, 0), cA, voffA); PG8_STAGE(PG8_SA(0, 1), cA + hstep, voffA);
        if (wr == 1) PG8_BAR;
        PG8_WAIT_V(2); PG8_BAR;
        PG8_STAGE(PG8_SB(1, 0), cB + kstep, voffB); PG8_STAGE(PG8_SA(1, 0), cA + kstep, voffA); PG8_STAGE(PG8_SB(1, 1), cB + hstep + kstep, voffB);
        PG8_WAIT_V(6); PG8_BAR;
    } else {
        PG8_STAGE(PG8_SB(0, 0), cB, voffB); PG8_STAGE(PG8_SA(0, 0), cA, voffA); PG8_STAGE(PG8_SB(0, 1), cB + hstep, voffB); PG8_STAGE(PG8_SA(0, 1), cA + hstep, voffA);
        if (wr == 1) PG8_BAR;
        PG8_WAIT_V(4); PG8_BAR;
        PG8_STAGE(PG8_SB(1, 0), cB + kstep, voffB); PG8_STAGE(PG8_SA(1, 0), cA + kstep, voffA); PG8_STAGE(PG8_SB(1, 1), cB + hstep + kstep, voffB);
        PG8_WAIT_V(6); PG8_BAR;
    }
    for (;;) {
        const bool has_next = S.next(ui + 1, nxt);
        const char* nA = has_next ? (const char*)g.A + (size_t)nxt.pm * tstep : cA; const char* nB = has_next ? (const char*)g.Bt + (size_t)nxt.pn * tstep : cB;
        for (int t = 0; t < nt; t += 2) {
            const bool last = (t == nt - 2);
            const char* a1 = cA + (size_t)(t + 1) * kstep;
            const char* a2 = last ? nA : cA + (size_t)(t + 2) * kstep; const char* b2 = last ? nB : cB + (size_t)(t + 2) * kstep;
            const char* a3 = a2 + kstep; const char* b3 = b2 + kstep;
            if (last && has_next) S.a_ready(nxt);
            if constexpr (SP2) {
            PG8_LDB(B0, 0, 0); PG8_LDB(B1, 0, 1); PG8_SCHED; PG8_LDA(At, 0, 0); PG8_STAGE(PG8_SA(1, 1), a1 + hstep, voffA);
            PG8_WAIT_V(8); PG8_WAIT_L(0); PG8_BAR; PG8_MMA(0, 0, At, B0); PG8_MMA(0, 1, At, B1); PG8_BAR; PG8_SCHED;
            PG8_LDA(At, 0, 1); PG8_STAGE(PG8_SB(0, 0), b2, voffB); PG8_STAGE(PG8_SB(0, 1), b2 + hstep, voffB); PG8_STAGE(PG8_SA(0, 0), a2, voffA);
            PG8_WAIT_V(8); PG8_WAIT_L(0); PG8_BAR; PG8_MMA(1, 0, At, B0); PG8_MMA(1, 1, At, B1); PG8_BAR; PG8_SCHED;
            PG8_LDB(B0, 1, 0); PG8_LDB(B1, 1, 1); PG8_SCHED; PG8_LDA(At, 1, 0); PG8_STAGE(PG8_SA(0, 1), a2 + hstep, voffA);
            PG8_WAIT_V(8); PG8_WAIT_L(0); PG8_BAR; PG8_MMA(0, 0, At, B0); PG8_MMA(0, 1, At, B1); PG8_BAR; PG8_SCHED;
            PG8_LDA(At, 1, 1); PG8_STAGE(PG8_SB(1, 0), b3, voffB); PG8_STAGE(PG8_SB(1, 1), b3 + hstep, voffB); PG8_STAGE(PG8_SA(1, 0), a3, voffA);
            PG8_WAIT_V(8); PG8_WAIT_L(0); PG8_BAR; PG8_MMA(1, 0, At, B0); PG8_MMA(1, 1, At, B1); PG8_BAR; PG8_SCHED;
            } else {
            PG8_LDB(B0, 0, 0); PG8_SCHED; PG8_LDA(At, 0, 0); PG8_STAGE(PG8_SA(1, 1), a1 + hstep, voffA);
            PG8_WAIT_L(8); PG8_BAR; PG8_WAIT_L(0); PG8_MMA(0, 0, At, B0); PG8_BAR; PG8_SCHED;
            PG8_LDB(B1, 0, 1); PG8_STAGE(PG8_SB(0, 0), b2, voffB);
            PG8_BAR; PG8_WAIT_L(0); PG8_MMA(0, 1, At, B1); PG8_BAR;
            PG8_LDA(At, 0, 1); PG8_STAGE(PG8_SA(0, 0), a2, voffA);
            PG8_BAR; PG8_WAIT_L(0); PG8_MMA(1, 0, At, B0); PG8_BAR; PG8_SCHED;
            PG8_STAGE(PG8_SB(0, 1), b2 + hstep, voffB);
            PG8_WAIT_V(6); PG8_BAR; PG8_MMA(1, 1, At, B1); PG8_BAR;
            PG8_LDB(B0, 1, 0); PG8_SCHED; PG8_LDA(At, 1, 0); PG8_STAGE(PG8_SA(0, 1), a2 + hstep, voffA);
            PG8_WAIT_L(8); PG8_BAR; PG8_WAIT_L(0); PG8_MMA(0, 0, At, B0); PG8_BAR; PG8_SCHED;
            PG8_LDB(B1, 1, 1); PG8_STAGE(PG8_SB(1, 0), b3, voffB);
            PG8_BAR; PG8_WAIT_L(0); PG8_MMA(0, 1, At, B1); PG8_BAR;
            PG8_LDA(At, 1, 1); PG8_STAGE(PG8_SA(1, 0), a3, voffA);
            PG8_BAR; PG8_WAIT_L(0); PG8_MMA(1, 0, At, B0); PG8_BAR; PG8_SCHED;
            PG8_STAGE(PG8_SB(1, 1), b3 + hstep, voffB);
            PG8_WAIT_V(6); PG8_BAR; PG8_MMA(1, 1, At, B1); PG8_BAR;
            }
        }
        if constexpr (ALIGN_EPI) { if (wr == 0) PG8_BAR; }
        if constexpr (!Epi::AFTER_DRAIN) { E(acc, cur, wr, wc, fr, fq); S.done(cur); }
        if (!has_next) break;
#pragma unroll
        for (int a = 0; a < 2; ++a)
#pragma unroll
            for (int b = 0; b < 2; ++b)
#pragma unroll
                for (int m = 0; m < 4; ++m)
#pragma unroll
                    for (int n = 0; n < 2; ++n) acc[a][b][m][n] = (f32x4){0.f, 0.f, 0.f, 0.f};
        cur = nxt; cA = nA; cB = nB; ++ui;
        if constexpr (ALIGN_EPI) { if (wr == 1) PG8_BAR; }
    }
    PG8_WAIT_V(0);
    if constexpr (!ALIGN_EPI) { if (wr == 0) PG8_BAR; }
    PG8_BAR;
    if constexpr (Epi::AFTER_DRAIN) { E.fused(acc, cur, wr, wc, fr, fq, lds, wid, lane); S.done(cur); }
#undef PG8_SA
#undef PG8_SB
#undef PG8_STAGE
#undef PG8_LDA
#undef PG8_LDB
#undef PG8_MMA
#undef PG8_WAIT_V
#undef PG8_WAIT_L
#undef PG8_BAR
#undef PG8_SCHED
}
}
typedef unsigned short bf16_t;
typedef short bf16x8 __attribute__((ext_vector_type(8)));
typedef float f32x4 __attribute__((ext_vector_type(4)));
typedef float f32x16 __attribute__((ext_vector_type(16)));
typedef unsigned u32x4 __attribute__((ext_vector_type(4)));
typedef unsigned u32x2 __attribute__((ext_vector_type(2)));
typedef __bf16 bf16x2v __attribute__((ext_vector_type(2)));

#define T_TOK 32768
#define SEQ 2048
#define DM 1024
#define MB(x) ((size_t)(x) << 20)

struct P {
    const float *x, *norm_mix_g, *norm_ffn_g, *final_g, *w_in, *sgu_norm_g, *sgu_w, *sgu_b, *w_out, *lam_re, *lam_im, *b_re, *b_im, *c_re, *c_im,
        *s5_d, *log_step, *glu_w, *glu_b, *wq, *subkeys, *pu, *pv;
    float* out;
    unsigned char* ws;
    int ph_lo, ph_hi, rep_ph, rep_n;
};
#define WS_XB MB(0)
#define WS_BIG MB(64)
#define WS_Q (WS_BIG)
#define WS_K (WS_BIG + MB(32))
#define WS_VT (WS_BIG + MB(64))
#define WS_UG (WS_BIG + MB(96))
#define WS_GG (WS_BIG + MB(128))
#define WS_MIXB (WS_BIG + MB(160))
#define WS_SCORES (WS_BIG)
#define WS_GBUF (WS_BIG)
#define WS_UTAB MB(320)
#define WS_VTAB MB(352)
#define WS_IDX MB(384)
#define WS_GATE MB(400)
#define WS_WTIN MB(416)
#define WS_WTOUT MB(421)
#define WS_WTGLU MB(423)
#define WS_WQK MB(425)
#define WS_KTAB MB(433)
#define WS_ME MB(436)
#define WS_MY MB(452)
#define WS_SSA MB(468)
#define WS_SSB (MB(468) + (128 << 10))
#define WS_LAM64 (MB(468) + (256 << 10))
#define WS_SU (MB(468) + (320 << 10))
#define WS_SV (MB(468) + (448 << 10))
#define WS_BAR (MB(468) + (576 << 10))
#define WS_END MB(469)

__device__ __forceinline__ unsigned cvt_pk_bf16(float lo, float hi) { unsigned r; asm volatile("v_cvt_pk_bf16_f32 %0, %1, %2" : "=v"(r) : "v"(lo), "v"(hi)); return r; }
__device__ __forceinline__ float bf_lo(unsigned u) { return __uint_as_float(u << 16); }
__device__ __forceinline__ float bf_hi(unsigned u) { return __uint_as_float(u & 0xffff0000u); }
__device__ __forceinline__ float gelu_t(float x) {
    const float u = 1.5957691216057308f * (x + 0.044715f * x * x * x);
    return x * __builtin_amdgcn_rcpf(1.0f + __expf(-u));
}
__device__ __forceinline__ float wave_sum(float v) {
#pragma unroll
    for (int o = 32; o > 0; o >>= 1) v += __shfl_xor(v, o);
    return v;
}
__device__ __forceinline__ bf16x8 pack8(float a0, float a1, float a2, float a3, float a4, float a5, float a6, float a7) {
    u32x4 r; r.x = cvt_pk_bf16(a0, a1); r.y = cvt_pk_bf16(a2, a3); r.z = cvt_pk_bf16(a4, a5); r.w = cvt_pk_bf16(a6, a7);
    return __builtin_bit_cast(bf16x8, r);
}
#define MFMA16(a, b, c) __builtin_amdgcn_mfma_f32_16x16x32_bf16((a), (b), (c), 0, 0, 0)
#define MFMA32(a, b, c) __builtin_amdgcn_mfma_f32_32x32x16_bf16((a), (b), (c), 0, 0, 0)

typedef f32x4 acc_t[2][2][4][2];

struct EpiIn {
    bf16_t *Q, *K, *VT, *UG, *GG;
    static constexpr bool PERM = false, AFTER_DRAIN = false;
    __device__ __forceinline__ void operator()(const acc_t& acc, const pg8::Unit& u, int wr, int wc, int fr_, int fq_) const {
        const int pm = u.pm, pn = u.pn; int fr = fr_, fq = fq_; asm volatile("" : "+v"(fr), "+v"(fq));
        const int region = pn >> 1, hg = (pn & 1) * 4 + wc;
        if (region <= 1) {
            bf16_t* base = region == 0 ? Q : K; const float sc = region == 0 ? 0.125f * 1.4426950408889634f : 1.0f;
            float invrev[2][4];
#pragma unroll
            for (int n = 0; n < 2; ++n)
#pragma unroll
                for (int j = 0; j < 4; ++j) invrev[n][j] = exp2f(-(float)(n * 16 + fq * 4 + j) * (13.287712379549449f / 32.0f)) * 0.15915494309189535f;
#pragma unroll
            for (int ai = 0; ai < 2; ++ai)
#pragma unroll
                for (int m = 0; m < 4; ++m) {
                    const int t = pm * 256 + ai * 128 + wr * 64 + m * 16 + fr, b = t >> 11, pos = t & 2047;
                    bf16_t* rowp = base + ((size_t)(b * 8 + hg) * SEQ + pos) * 64;
#pragma unroll
                    for (int n = 0; n < 2; ++n) {
                        float o1[4], o2[4];
#pragma unroll
                        for (int j = 0; j < 4; ++j) {
                            const float rev = __builtin_amdgcn_fractf((float)pos * invrev[n][j]);
                            const float sn = __builtin_amdgcn_sinf(rev), cs = __builtin_amdgcn_cosf(rev);
                            const float x1 = acc[ai][0][m][n][j], x2 = acc[ai][1][m][n][j];
                            o1[j] = (x1 * cs - x2 * sn) * sc; o2[j] = (x2 * cs + x1 * sn) * sc;
                        }
                        u32x2 w1, w2; w1.x = cvt_pk_bf16(o1[0], o1[1]); w1.y = cvt_pk_bf16(o1[2], o1[3]); w2.x = cvt_pk_bf16(o2[0], o2[1]); w2.y = cvt_pk_bf16(o2[2], o2[3]);
                        *(u32x2*)(rowp + n * 16 + fq * 4) = w1; *(u32x2*)(rowp + 32 + n * 16 + fq * 4) = w2;
                    }
                    __builtin_amdgcn_sched_barrier(0);
                }
        } else if (region == 2) {
#pragma unroll
            for (int ai = 0; ai < 2; ++ai) {
                const int t0 = pm * 256 + ai * 128 + wr * 64, b = t0 >> 11, i0 = (t0 & 2047) >> 4;
                bf16_t* vb = VT + (size_t)(b * 8 + hg) * 64 * SEQ + fr * 128 + i0;
#pragma unroll
                for (int bj = 0; bj < 2; ++bj)
#pragma unroll
                    for (int n = 0; n < 2; ++n)
#pragma unroll
                        for (int j = 0; j < 4; ++j) {
                            const int d = bj * 32 + n * 16 + fq * 4 + j;
                            u32x2 w; w.x = cvt_pk_bf16(acc[ai][bj][0][n][j], acc[ai][bj][1][n][j]); w.y = cvt_pk_bf16(acc[ai][bj][2][n][j], acc[ai][bj][3][n][j]);
                            *(u32x2*)(vb + (size_t)d * SEQ) = w;
                        }
                __builtin_amdgcn_sched_barrier(0);
            }
        } else {
            bf16_t* base = region == 3 ? UG : GG;
#pragma unroll
            for (int ai = 0; ai < 2; ++ai)
#pragma unroll
                for (int m = 0; m < 4; ++m) {
                    const int t = pm * 256 + ai * 128 + wr * 64 + m * 16 + fr;
                    bf16_t* rowp = base + (size_t)t * 512 + hg * 64;
#pragma unroll
                    for (int bj = 0; bj < 2; ++bj)
#pragma unroll
                        for (int n = 0; n < 2; ++n) {
                            const f32x4 v = acc[ai][bj][m][n];
                            u32x2 w; w.x = cvt_pk_bf16(gelu_t(v[0]), gelu_t(v[1])); w.y = cvt_pk_bf16(gelu_t(v[2]), gelu_t(v[3]));
                            *(u32x2*)(rowp + bj * 32 + n * 16 + fq * 4) = w;
                        }
                    __builtin_amdgcn_sched_barrier(0);
                }
        }
    }
};

struct EpiRes {
    const float* xin; float* xout; bf16_t* XB; float* sumsq; bool dry;
    static constexpr bool PERM = false, AFTER_DRAIN = false;
    __device__ __forceinline__ void operator()(const acc_t& acc, const pg8::Unit& u, int wr, int wc, int fr_, int fq_) const {
        const int pm = u.pm, pn = u.pn; int fr = fr_, fq = fq_; asm volatile("" : "+v"(fr), "+v"(fq));
#pragma unroll
        for (int ai = 0; ai < 2; ++ai) {
            f32x4 xv[4][2][2];
#pragma unroll
            for (int m = 0; m < 4; ++m)
#pragma unroll
                for (int bj = 0; bj < 2; ++bj)
#pragma unroll
                    for (int n = 0; n < 2; ++n) xv[m][bj][n] = *(const f32x4*)(xin + (size_t)(pm * 256 + ai * 128 + wr * 64 + m * 16 + fr) * DM + pn * 256 + bj * 128 + wc * 32 + n * 16 + fq * 4);
#pragma unroll
            for (int m = 0; m < 4; ++m) {
                const int t = pm * 256 + ai * 128 + wr * 64 + m * 16 + fr; float ss = 0.f;
#pragma unroll
                for (int bj = 0; bj < 2; ++bj)
#pragma unroll
                    for (int n = 0; n < 2; ++n) {
                        const size_t off = (size_t)t * DM + pn * 256 + bj * 128 + wc * 32 + n * 16 + fq * 4;
                        const f32x4 v = xv[m][bj][n] + acc[ai][bj][m][n];
                        u32x2 w; w.x = cvt_pk_bf16(v[0], v[1]); w.y = cvt_pk_bf16(v[2], v[3]);
                        if (!dry) *(u32x2*)(XB + off) = w;
                        ss += (v[0] * v[0] + v[1] * v[1]) + (v[2] * v[2] + v[3] * v[3]);
                    }
                ss += __shfl_xor(ss, 16); ss += __shfl_xor(ss, 32);
                if (fq == 0 && !dry) atomicAdd(sumsq + t, ss);
            }
            __builtin_amdgcn_sched_barrier(0);
        }
    }
};
__device__ __forceinline__ void pro_rmsnorm_rows(const float* __restrict__ x, const float* __restrict__ g, bf16_t* __restrict__ XB, int gw, int nw, int lane) {
    for (int t0 = gw * 2; t0 < T_TOK; t0 += nw * 2) {
        f32x4 v[2][4]; float ss[2];
#pragma unroll
        for (int u = 0; u < 2; ++u) { const float* xr = x + (size_t)(t0 + u) * DM + lane * 16;
#pragma unroll
            for (int i = 0; i < 4; ++i) v[u][i] = *(const f32x4*)(xr + 4 * i); }
#pragma unroll
        for (int u = 0; u < 2; ++u) { ss[u] = 0.f;
#pragma unroll
            for (int i = 0; i < 4; ++i) ss[u] += (v[u][i][0] * v[u][i][0] + v[u][i][1] * v[u][i][1]) + (v[u][i][2] * v[u][i][2] + v[u][i][3] * v[u][i][3]); }
#pragma unroll
        for (int o = 32; o > 0; o >>= 1) { ss[0] += __shfl_xor(ss[0], o); ss[1] += __shfl_xor(ss[1], o); }
#pragma unroll
        for (int u = 0; u < 2; ++u) {
            const float rs = rsqrtf(ss[u] * (1.0f / DM) + 1e-6f);
            u32x4 o[2];
#pragma unroll
            for (int i = 0; i < 4; ++i) { const f32x4 gv = *(const f32x4*)(g + lane * 16 + 4 * i); const f32x4 r = v[u][i] * gv * rs;
                const unsigned a = cvt_pk_bf16(r[0], r[1]), b = cvt_pk_bf16(r[2], r[3]);
                if ((i & 1) == 0) { o[i >> 1].x = a; o[i >> 1].y = b; } else { o[i >> 1].z = a; o[i >> 1].w = b; } }
            *(u32x4*)(XB + (size_t)(t0 + u) * DM + lane * 16) = o[0]; *(u32x4*)(XB + (size_t)(t0 + u) * DM + lane * 16 + 8) = o[1];
        }
    }
}
template <bool PERM>
__device__ __forceinline__ void pro_transpose(const float* __restrict__ W, int N, const float* __restrict__ g, bf16_t* __restrict__ Wt, int gtid, int nthr) {
    const int items = N * 128;
    for (int it = gtid; it < items; it += nthr) {
        const int n = it % N, k0 = (it / N) * 8; float v[8];
#pragma unroll
        for (int i = 0; i < 8; ++i) v[i] = W[(size_t)(k0 + i) * N + n] * (g ? g[k0 + i] : 1.0f);
        int np = n;
        if (PERM) { const int tl = n >> 8, l = n & 255, wc = l >> 6, bj = (l >> 5) & 1, r32 = l & 31; np = tl * 256 + bj * 128 + wc * 32 + r32; }
        *(bf16x8*)(Wt + (size_t)np * 1024 + k0) = pack8(v[0], v[1], v[2], v[3], v[4], v[5], v[6], v[7]);
    }
}

__device__ __forceinline__ void attn_range4(int cls, int r4, int tb0, int& i0, int& i_hi) {
    const bool special = ((cls ^ r4) & 3) == 0;
    int lo_s = special ? 0 : tb0 - 128; if (lo_s < 0) lo_s = 0;
    int i_lo = (lo_s - cls + 15) >> 4; if (i_lo < 0) i_lo = 0;
    i_hi = (tb0 + 12 + 240 - cls) >> 4; i0 = i_lo & ~7;
}
__device__ __forceinline__ void phase_attn(const bf16_t* __restrict__ Q, const bf16_t* __restrict__ Kp, const bf16_t* __restrict__ VT, bf16_t* __restrict__ MIXB, int gw, int nw, int lane) {
    const int x = lane & 15, g = lane >> 4;
    for (int job = gw; job < 4096; job += nw) {
        const int bh = job >> 5, rem = job & 31, r4 = rem & 3;
        const int jblk = (job >= 2048) ? 7 - (rem >> 2) : (rem >> 2);
        const int tb0 = jblk * 256 + r4;
        bf16x8 q0[4], q1[4]; f32x4 o[4][4]; float m[4], l[4];
#pragma unroll
        for (int u = 0; u < 4; ++u) {
            const bf16_t* Qp = Q + ((size_t)bh * SEQ + tb0 + 4 * u + 16 * x) * 64 + 8 * g;
            q0[u] = *(const bf16x8*)Qp; q1[u] = *(const bf16x8*)(Qp + 32); m[u] = -1e30f; l[u] = 0.f;
#pragma unroll
            for (int n = 0; n < 4; ++n) o[u][n] = (f32x4){0.f, 0.f, 0.f, 0.f};
        }
        const bf16_t* Kb = Kp + (size_t)bh * SEQ * 64 + 8 * g;
        const bf16_t* Vb = VT + (size_t)bh * 64 * SEQ + (size_t)x * SEQ;
        const int xo = 8 * (x >> 2) + (x & 3);
        int cls = 0, ib, i_hi; attn_range4(0, r4, tb0, ib, i_hi);
        bf16x8 kc[4], vc[4];
#define ATTN_LOADK(KD, CLS, IB) do { const int _iA = (IB) + xo, _iB = _iA + 4; const int _iAc = _iA < 127 ? _iA : 127, _iBc = _iB < 127 ? _iB : 127; \
            const bf16_t* _ka = Kb + (size_t)((CLS) + 16 * _iAc) * 64; const bf16_t* _kb = Kb + (size_t)((CLS) + 16 * _iBc) * 64; \
            KD[0] = *(const bf16x8*)_ka; KD[1] = *(const bf16x8*)(_ka + 32); KD[2] = *(const bf16x8*)_kb; KD[3] = *(const bf16x8*)(_kb + 32); } while (0)
#define ATTN_LOADV(VD, CLS, IB) do { int _iv = (IB) + 8 * g; if (_iv > 120) _iv = 120; \
            _Pragma("unroll") for (int n = 0; n < 4; ++n) VD[n] = *(const bf16x8*)(Vb + (size_t)(16 * n) * SEQ + (CLS) * 128 + _iv); } while (0)
        ATTN_LOADK(kc, cls, ib);
        bool more = true;
#pragma unroll 1
        while (more) {
            ATTN_LOADV(vc, cls, ib);
            int ncls = cls, nib = ib + 32, nhi = i_hi;
            if (nib > i_hi) { ncls = cls + 1; if (ncls < 16) attn_range4(ncls, r4, tb0, nib, nhi); }
            more = ncls < 16;
            bf16x8 kn[4];
            { const int lc = more ? ncls : cls, li = more ? nib : ib; ATTN_LOADK(kn, lc, li); }
            const bool special = ((cls ^ r4) & 3) == 0; const int ustar = (cls - r4) >> 2;
            const int dbase = tb0 + 16 * x - cls - 16 * (ib + 8 * g);
#pragma unroll
            for (int u = 0; u < 4; ++u) {
                const int c3 = (special && u == ustar) ? 1 : 0;
                f32x4 sA = (f32x4){0.f, 0.f, 0.f, 0.f}, sB = (f32x4){0.f, 0.f, 0.f, 0.f};
                sA = MFMA16(kc[0], q0[u], sA); sA = MFMA16(kc[1], q1[u], sA);
                sB = MFMA16(kc[2], q0[u], sB); sB = MFMA16(kc[3], q1[u], sB);
                float sc[8]; float mt = -INFINITY;
                if (special) {
#pragma unroll
                    for (int jj = 0; jj < 8; ++jj) {
                        const int delta = dbase + 4 * u - 16 * jj;
                        const int mult = (delta >= 0) ? (c3 + (delta <= 512 ? 1 : 0) + (delta <= 128 ? 1 : 0)) : 0;
                        const float bias = mult == 3 ? 1.584962500721156f : (mult == 2 ? 1.0f : 0.0f);
                        const float s = (jj < 4 ? sA[jj & 3] : sB[jj & 3]) + bias;
                        sc[jj] = mult > 0 ? s : -INFINITY; mt = fmaxf(mt, sc[jj]);
                    }
                } else {
#pragma unroll
                    for (int jj = 0; jj < 8; ++jj) {
                        const unsigned delta = (unsigned)(dbase + 4 * u - 16 * jj);
                        sc[jj] = delta <= 128u ? (jj < 4 ? sA[jj & 3] : sB[jj & 3]) : -INFINITY; mt = fmaxf(mt, sc[jj]);
                    }
                }
                { const auto s16 = __builtin_amdgcn_permlane16_swap(__float_as_uint(mt), __float_as_uint(mt), false, false); mt = fmaxf(__uint_as_float(s16[0]), __uint_as_float(s16[1]));
                  const auto s32 = __builtin_amdgcn_permlane32_swap(__float_as_uint(mt), __float_as_uint(mt), false, false); mt = fmaxf(__uint_as_float(s32[0]), __uint_as_float(s32[1])); }
                if (__builtin_amdgcn_ballot_w64(mt > m[u]) != 0ull) {
                    const float mn = fmaxf(m[u], mt), alpha = __builtin_amdgcn_exp2f(m[u] - mn); m[u] = mn; l[u] *= alpha;
#pragma unroll
                    for (int n = 0; n < 4; ++n) o[u][n] = o[u][n] * alpha;
                }
                const float mn = m[u];
                float pj[8], ps = 0.f;
#pragma unroll
                for (int jj = 0; jj < 8; ++jj) { pj[jj] = __builtin_amdgcn_exp2f(sc[jj] - mn); ps += pj[jj]; }
                l[u] += ps;
                const bf16x8 pf = pack8(pj[0], pj[1], pj[2], pj[3], pj[4], pj[5], pj[6], pj[7]);
#pragma unroll
                for (int n = 0; n < 4; ++n) o[u][n] = MFMA16(vc[n], pf, o[u][n]);
            }
#pragma unroll
            for (int n = 0; n < 4; ++n) kc[n] = kn[n];
            cls = ncls; ib = nib; i_hi = nhi;
        }
#undef ATTN_LOADK
#undef ATTN_LOADV
        const int b = bh >> 3, h = bh & 7;
#pragma unroll
        for (int u = 0; u < 4; ++u) {
            float lt = l[u]; lt += __shfl_xor(lt, 16); lt += __shfl_xor(lt, 32);
            const float inv = 1.0f / lt;
            bf16_t* op = MIXB + (size_t)(b * SEQ + tb0 + 4 * u + 16 * x) * DM + h * 64 + 4 * g;
#pragma unroll
            for (int n = 0; n < 4; ++n) { u32x2 w; w.x = cvt_pk_bf16(o[u][n][0] * inv, o[u][n][1] * inv); w.y = cvt_pk_bf16(o[u][n][2] * inv, o[u][n][3] * inv); *(u32x2*)(op + 16 * n) = w; }
        }
    }
}

__device__ __forceinline__ void phase_sgu(const bf16_t* __restrict__ UG, const bf16_t* __restrict__ GG, const float* __restrict__ sgn, const float* __restrict__ sgw,
                                          const float* __restrict__ sgb, bf16_t* __restrict__ MIXB, unsigned char* smem) {
    bf16_t* GT = (bf16_t*)smem;
    int tid_ = threadIdx.x; asm volatile("" : "+v"(tid_));
    const int tid = tid_, lane = tid & 63, w = tid >> 6, x = lane & 15, g = lane >> 4;
    for (int item = blockIdx.x; item < 2048; item += gridDim.x) {
        const int h = item & 7, t0 = (item >> 3) * 128;
        __syncthreads();
#pragma unroll
        for (int pass = 0; pass < 2; ++pass) {
            const int j = pass * 64 + (tid >> 3), part = tid & 7;
            const u32x4 raw = *(const u32x4*)(GG + (size_t)(t0 + j) * 512 + h * 64 + part * 8);
            float v[8] = {bf_lo(raw.x), bf_hi(raw.x), bf_lo(raw.y), bf_hi(raw.y), bf_lo(raw.z), bf_hi(raw.z), bf_lo(raw.w), bf_hi(raw.w)};
            float s = 0.f;
#pragma unroll
            for (int e = 0; e < 8; ++e) s += v[e];
            s += __shfl_xor(s, 1); s += __shfl_xor(s, 2); s += __shfl_xor(s, 4);
            const float mu = s * (1.0f / 64.0f); float q = 0.f;
#pragma unroll
            for (int e = 0; e < 8; ++e) { v[e] -= mu; q += v[e] * v[e]; }
            q += __shfl_xor(q, 1); q += __shfl_xor(q, 2); q += __shfl_xor(q, 4);
            const float rs = rsqrtf(q * (1.0f / 64.0f) + 1e-5f);
#pragma unroll
            for (int e = 0; e < 8; ++e) GT[(part * 8 + e) * 136 + j] = (bf16_t)(cvt_pk_bf16(v[e] * rs * sgn[h * 64 + part * 8 + e], 0.f) & 0xffffu);
        }
        __syncthreads();
        const int i = 16 * w + x;
        f32x4 acc[4];
#pragma unroll
        for (int n = 0; n < 4; ++n) acc[n] = (f32x4){0.f, 0.f, 0.f, 0.f};
        const int ksmax = (16 * w + 15) >> 5;
        for (int ks = 0; ks <= ksmax; ++ks) {
            const float* wp = sgw + (size_t)(h * 128 + i) * 128 + 32 * ks + 8 * g;
            const f32x4 w0 = *(const f32x4*)wp, w1 = *(const f32x4*)(wp + 4);
            const int jb = 32 * ks + 8 * g;
            const bf16x8 wf = pack8(jb + 0 <= i ? w0[0] : 0.f, jb + 1 <= i ? w0[1] : 0.f, jb + 2 <= i ? w0[2] : 0.f, jb + 3 <= i ? w0[3] : 0.f,
                                    jb + 4 <= i ? w1[0] : 0.f, jb + 5 <= i ? w1[1] : 0.f, jb + 6 <= i ? w1[2] : 0.f, jb + 7 <= i ? w1[3] : 0.f);
#pragma unroll
            for (int n = 0; n < 4; ++n) { const bf16x8 af = *(const bf16x8*)(GT + (16 * n + x) * 136 + 32 * ks + 8 * g); acc[n] = MFMA16(af, wf, acc[n]); }
        }
        const float bi = sgb[h * 128 + i]; const size_t t = (size_t)t0 + i;
#pragma unroll
        for (int n = 0; n < 4; ++n) {
            const u32x2 ur = *(const u32x2*)(UG + t * 512 + h * 64 + 16 * n + 4 * g);
            u32x2 o; o.x = cvt_pk_bf16(bf_lo(ur.x) * (acc[n][0] + bi), bf_hi(ur.x) * (acc[n][1] + bi)); o.y = cvt_pk_bf16(bf_lo(ur.y) * (acc[n][2] + bi), bf_hi(ur.y) * (acc[n][3] + bi));
            *(u32x2*)(MIXB + t * DM + 512 + h * 64 + 16 * n + 4 * g) = o;
        }
    }
}
__device__ __forceinline__ void pro_wqk(const float* __restrict__ wq, const float* __restrict__ sk, const float* __restrict__ gffn, bf16_t* __restrict__ Wqk, int gw, int nw, int lane) {
    const int r = lane & 31, half = lane >> 5;
    for (int tile = gw; tile < 4096; tile += nw) {
        const int kblk = tile & 31, kb = (tile >> 5) & 3, hp = (tile >> 7) & 15, l = tile >> 11, p = hp & 1;
        const float* ap = sk + ((size_t)((l * 2 + p) * 128 + kb * 32 + r)) * 128 + 64 * half;
        const float* bp = wq + ((size_t)l * 1024 + kblk * 32 + r) * 2048 + hp * 128 + 64 * half;
        f32x16 acc;
#pragma unroll
        for (int i = 0; i < 16; ++i) acc[i] = 0.f;
#pragma unroll
        for (int ch = 0; ch < 4; ++ch) {
            f32x4 a[4], b[4];
#pragma unroll
            for (int i = 0; i < 4; ++i) { a[i] = *(const f32x4*)(ap + ch * 16 + 4 * i); b[i] = *(const f32x4*)(bp + ch * 16 + 4 * i); }
#pragma unroll
            for (int i = 0; i < 4; ++i)
#pragma unroll
                for (int j = 0; j < 4; ++j) acc = __builtin_amdgcn_mfma_f32_32x32x2f32(a[i][j], b[i][j], acc, 0, 0, 0);
        }
        const float gk = gffn[l * 1024 + kblk * 32 + r];
        bf16_t* op = Wqk + ((size_t)l * 2048 + hp * 128 + kb * 32) * 1024 + kblk * 32 + r;
#pragma unroll
        for (int i = 0; i < 16; ++i) { const int row = (i & 3) + 8 * (i >> 2) + 4 * half; op[(size_t)row * 1024] = (bf16_t)(cvt_pk_bf16(acc[i] * gk, 0.f) & 0xffffu); }
    }
}
__device__ __forceinline__ void pro_tables(const float* __restrict__ pu, const float* __restrict__ pv, const float* __restrict__ g, bf16_t* __restrict__ Ut, bf16_t* __restrict__ Vt, int gtid, int nthr) {
    const int items = 16384 * 128;
    for (int it = gtid; it < items; it += nthr) {
        const size_t off = (size_t)it * 8; const int d = (it & 127) * 8;
        const f32x4 a0 = *(const f32x4*)(pu + off), a1 = *(const f32x4*)(pu + off + 4), g0 = *(const f32x4*)(g + d), g1 = *(const f32x4*)(g + d + 4);
        *(bf16x8*)(Ut + off) = pack8(a0[0] * g0[0], a0[1] * g0[1], a0[2] * g0[2], a0[3] * g0[3], a1[0] * g1[0], a1[1] * g1[1], a1[2] * g1[2], a1[3] * g1[3]);
        const f32x4 b0 = *(const f32x4*)(pv + off), b1 = *(const f32x4*)(pv + off + 4);
        *(bf16x8*)(Vt + off) = pack8(b0[0], b0[1], b0[2], b0[3], b1[0], b1[1], b1[2], b1[3]);
    }
}

struct EpiScores {
    const float* sumsq; float* ST;
    static constexpr bool PERM = false, AFTER_DRAIN = false;
    __device__ __forceinline__ void operator()(const acc_t& acc, const pg8::Unit& u, int wr, int wc, int fr_, int fq_) const {
        const int pm = u.pm, pn = u.pn; int fr = fr_, fq = fq_; asm volatile("" : "+v"(fr), "+v"(fq));
        float ssq[2][4];
#pragma unroll
        for (int ai = 0; ai < 2; ++ai)
#pragma unroll
            for (int m = 0; m < 4; ++m) ssq[ai][m] = sumsq[pm * 256 + ai * 128 + wr * 64 + m * 16 + fr];
#pragma unroll
        for (int ai = 0; ai < 2; ++ai)
#pragma unroll
            for (int m = 0; m < 4; ++m) {
                const int t = pm * 256 + ai * 128 + wr * 64 + m * 16 + fr;
                const float rs = rsqrtf(ssq[ai][m] * (1.0f / DM) + 1e-6f);
                float* base = ST + (((size_t)(t >> 6) * 512 + pn * 64 + wc * 8 + fq) * 64 + (t & 63)) * 4;
#pragma unroll
                for (int bj = 0; bj < 2; ++bj)
#pragma unroll
                    for (int n = 0; n < 2; ++n) *(f32x4*)(base + (size_t)(bj * 32 + n * 4) * 256) = acc[ai][bj][m][n] * rs;
                __builtin_amdgcn_sched_barrier(0);
            }
    }
};

__device__ __forceinline__ unsigned ord_key(float f) { const unsigned u = __float_as_uint(f); return (u & 0x80000000u) ? ~u : (u | 0x80000000u); }
__device__ __forceinline__ float ord_val(unsigned k) { const unsigned u = (k & 0x80000000u) ? (k & 0x7fffffffu) : ~k; return __uint_as_float(u); }
#define INS16(A, KEY) do { unsigned _k = (KEY); _Pragma("unroll") for (int _s = 0; _s < 16; ++_s) { const unsigned _hi = max(A[_s], _k); _k = min(A[_s], _k); A[_s] = _hi; } } while (0)


#define TK_CE(A, I, J) do { const unsigned _h = max(A[I], A[J]), _l = min(A[I], A[J]); A[I] = _h; A[J] = _l; } while (0)
__device__ __forceinline__ void tk_sort16(unsigned (&v)[16]) {
#pragma unroll
    for (int k = 2; k <= 16; k <<= 1)
#pragma unroll
        for (int j = k >> 1; j >= 1; j >>= 1)
#pragma unroll
            for (int i = 0; i < 16; ++i) { const int l = i ^ j; if (l > i) { if ((i & k) == 0 || k == 16) TK_CE(v, i, l); else TK_CE(v, l, i); } }
}
__device__ __forceinline__ void tk_merge16(unsigned (&a)[16], const unsigned (&b)[16]) {
#pragma unroll
    for (int i = 0; i < 16; ++i) a[i] = max(a[i], b[15 - i]);
#pragma unroll
    for (int j = 8; j >= 1; j >>= 1)
#pragma unroll
        for (int i = 0; i < 16; ++i) { const int l = i ^ j; if (l > i) TK_CE(a, i, l); }
}

__device__ __forceinline__ void topk_item(const float* __restrict__ ST, int* __restrict__ idx, float* __restrict__ gate, unsigned* L, int item, int tid, int lane) {
    {
        const int tt = item >> 3, h = item & 7;
        const float* sp = ST + (((size_t)tt * 512 + h * 64) * 64 + lane) * 4;
        unsigned a0[16], a1[16];
#pragma unroll
        for (int s = 0; s < 16; ++s) { a0[s] = 0u; a1[s] = 0u; }
        float bufk[3][32];
#define TK_LOAD(B, BLK) do { _Pragma("unroll") for (int i = 0; i < 8; ++i) { const f32x4 v = *(const f32x4*)(sp + (size_t)((BLK) * 8 + i) * 256); B[4 * i] = v[0]; B[4 * i + 1] = v[1]; B[4 * i + 2] = v[2]; B[4 * i + 3] = v[3]; } } while (0)
        TK_LOAD(bufk[0], 0); TK_LOAD(bufk[1], 1);
#pragma unroll
        for (int blk = 0; blk < 8; ++blk) {
            if (blk < 6) TK_LOAD(bufk[(blk + 2) % 3], blk + 2);
#pragma unroll
            for (int hb = 0; hb < 2; ++hb) {
                unsigned b16[16];
#pragma unroll
                for (int i = 0; i < 16; ++i) b16[i] = (ord_key(bufk[blk % 3][16 * hb + i]) & ~127u) | (unsigned)(127 - ((blk & 3) * 32 + 16 * hb + i));
                tk_sort16(b16);
                if (blk < 4) { if (blk == 0 && hb == 0) {
#pragma unroll
                        for (int i = 0; i < 16; ++i) a0[i] = b16[i]; } else tk_merge16(a0, b16); }
                else { if (blk == 4 && hb == 0) {
#pragma unroll
                        for (int i = 0; i < 16; ++i) a1[i] = b16[i]; } else tk_merge16(a1, b16); }
            }
        }
#undef TK_LOAD
#pragma unroll
        for (int s = 0; s < 16; ++s) { L[s * 512 + tid] = a0[s]; L[(16 + s) * 512 + tid] = a1[s]; }
        unsigned c[16];
#pragma unroll
        for (int s = 0; s < 16; ++s) c[s] = 0u;
#pragma unroll
        for (int ri = 0; ri < 16; ++ri)
#pragma unroll
            for (int rj = 0; rj < 16; ++rj)
                if ((ri + 1) * (rj + 1) <= 16) { const float sm = ord_val(a0[ri] & ~127u) + ord_val(a1[rj] & ~127u); const unsigned k = (ord_key(sm) & ~255u) | (unsigned)(255 - (ri * 16 + rj)); INS16(c, k); }
        float sv[16]; int ei[16]; float mx = -INFINITY;
#pragma unroll
        for (int s = 0; s < 16; ++s) {
            const unsigned code = 255u - (c[s] & 255u); const unsigned k0 = L[(code >> 4) * 512 + tid], k1 = L[(16 + (code & 15)) * 512 + tid];
            sv[s] = ord_val(k0 & ~127u) + ord_val(k1 & ~127u); ei[s] = (int)((127u - (k0 & 127u)) * 128u + (127u - (k1 & 127u))); mx = fmaxf(mx, sv[s]);
        }
        float sum = 0.f;
#pragma unroll
        for (int s = 0; s < 16; ++s) { sv[s] = __expf(sv[s] - mx); sum += sv[s]; }
        const float inv = 1.0f / sum; const size_t ob = ((size_t)tt * 64 + lane) * 128 + h * 16;
#pragma unroll
        for (int s = 0; s < 16; s += 4) {
            *(int4*)(idx + ob + s) = make_int4(ei[s], ei[s + 1], ei[s + 2], ei[s + 3]);
            *(f32x4*)(gate + ob + s) = (f32x4){sv[s] * inv, sv[s + 1] * inv, sv[s + 2] * inv, sv[s + 3] * inv};
        }
    }
}

__device__ __forceinline__ float dot2bf(unsigned a, unsigned b, float c) { return __builtin_amdgcn_fdot2_f32_bf16(__builtin_bit_cast(bf16x2v, a), __builtin_bit_cast(bf16x2v, b), c, false); }

template <int MODE>
__device__ __forceinline__ void phase_expert(const bf16_t* __restrict__ XB, const float* __restrict__ sumsq, const int* __restrict__ idx, const float* __restrict__ gate,
                                             const bf16_t* __restrict__ Ut, const bf16_t* __restrict__ Vt, float* __restrict__ x, const float* __restrict__ gnext,
                                             bf16_t* __restrict__ XBout, int gw, int nw, int lane, bool dry) {
    for (int t0 = gw; t0 < T_TOK; t0 += nw) {
        const int t = __builtin_amdgcn_readfirstlane(t0);
        const u32x4 xa = *(const u32x4*)(XB + (size_t)t * DM + lane * 16), xb = *(const u32x4*)(XB + (size_t)t * DM + lane * 16 + 8);
        const float rs = rsqrtf(sumsq[t] * (1.0f / DM) + 1e-6f);
        float y[16];
#pragma unroll
        for (int i = 0; i < 16; ++i) y[i] = 0.f;
        const int myp = (lane >> 3) & 7;
#pragma unroll 1
        for (int grp = 0; grp < 16; ++grp) {
            const int* ip = idx + (size_t)t * 128 + grp * 8;
            int e[8];
#pragma unroll
            for (int k = 0; k < 8; ++k) e[k] = __builtin_amdgcn_readfirstlane(ip[k]);
            u32x4 ua[8], ub[8];
#pragma unroll
            for (int k = 0; k < 8; ++k) { const bf16_t* up = Ut + (size_t)e[k] * DM + lane * 16; ua[k] = *(const u32x4*)up; ub[k] = *(const u32x4*)(up + 8); }
            float d[8];
#pragma unroll
            for (int k = 0; k < 8; ++k) {
                float s0 = dot2bf(ua[k].x, xa.x, 0.f), s1 = dot2bf(ua[k].y, xa.y, 0.f);
                s0 = dot2bf(ua[k].z, xa.z, s0); s1 = dot2bf(ua[k].w, xa.w, s1);
                s0 = dot2bf(ub[k].x, xb.x, s0); s1 = dot2bf(ub[k].y, xb.y, s1);
                s0 = dot2bf(ub[k].z, xb.z, s0); s1 = dot2bf(ub[k].w, xb.w, s1);
                d[k] = s0 + s1;
            }
            float r4[4], r2[2], r1;
            { const bool hi = (lane & 32) != 0;
#pragma unroll
              for (int i = 0; i < 4; ++i) { const float keep = hi ? d[i + 4] : d[i], send = hi ? d[i] : d[i + 4]; r4[i] = keep + __shfl_xor(send, 32); } }
            { const bool hi = (lane & 16) != 0;
#pragma unroll
              for (int i = 0; i < 2; ++i) { const float keep = hi ? r4[i + 2] : r4[i], send = hi ? r4[i] : r4[i + 2]; r2[i] = keep + __shfl_xor(send, 16); } }
            { const bool hi = (lane & 8) != 0; const float keep = hi ? r2[1] : r2[0], send = hi ? r2[0] : r2[1]; r1 = keep + __shfl_xor(send, 8); }
            r1 += __shfl_xor(r1, 4); r1 += __shfl_xor(r1, 2); r1 += __shfl_xor(r1, 1);
            const int pk = ((lane >> 5) & 1) * 4 + ((lane >> 4) & 1) * 2 + ((lane >> 3) & 1);
            const float gk = gate[(size_t)t * 128 + grp * 8 + pk];
            const float wgt = gk * gelu_t(r1 * rs);
            (void)myp;
#pragma unroll
            for (int k = 0; k < 8; ++k) {
                const float wk = __uint_as_float(__builtin_amdgcn_readlane(__float_as_uint(wgt), ((k >> 2) & 1) * 32 + ((k >> 1) & 1) * 16 + (k & 1) * 8));
                const bf16_t* vp = Vt + (size_t)e[k] * DM + lane * 16;
                const u32x4 va = *(const u32x4*)vp, vb = *(const u32x4*)(vp + 8);
                y[0] += wk * bf_lo(va.x); y[1] += wk * bf_hi(va.x); y[2] += wk * bf_lo(va.y); y[3] += wk * bf_hi(va.y);
                y[4] += wk * bf_lo(va.z); y[5] += wk * bf_hi(va.z); y[6] += wk * bf_lo(va.w); y[7] += wk * bf_hi(va.w);
                y[8] += wk * bf_lo(vb.x); y[9] += wk * bf_hi(vb.x); y[10] += wk * bf_lo(vb.y); y[11] += wk * bf_hi(vb.y);
                y[12] += wk * bf_lo(vb.z); y[13] += wk * bf_hi(vb.z); y[14] += wk * bf_lo(vb.w); y[15] += wk * bf_hi(vb.w);
            }
        }
        float* xr = x + (size_t)t * DM + lane * 16; float ss = 0.f; f32x4 xn[4];
#pragma unroll
        for (int i = 0; i < 4; ++i) { const f32x4 xv = *(const f32x4*)(xr + 4 * i); xn[i] = xv + (f32x4){y[4 * i], y[4 * i + 1], y[4 * i + 2], y[4 * i + 3]};
            ss += (xn[i][0] * xn[i][0] + xn[i][1] * xn[i][1]) + (xn[i][2] * xn[i][2] + xn[i][3] * xn[i][3]); }
        ss = wave_sum(ss); const float rn = rsqrtf(ss * (1.0f / DM) + 1e-6f);
        if (dry) continue;
        if (MODE == 0) {
            u32x4 o[2];
#pragma unroll
            for (int i = 0; i < 4; ++i) { *(f32x4*)(xr + 4 * i) = xn[i]; const f32x4 gv = *(const f32x4*)(gnext + lane * 16 + 4 * i); const f32x4 r = xn[i] * gv * rn;
                const unsigned a = cvt_pk_bf16(r[0], r[1]), b = cvt_pk_bf16(r[2], r[3]);
                if ((i & 1) == 0) { o[i >> 1].x = a; o[i >> 1].y = b; } else { o[i >> 1].z = a; o[i >> 1].w = b; } }
            *(u32x4*)(XBout + (size_t)t * DM + lane * 16) = o[0]; *(u32x4*)(XBout + (size_t)t * DM + lane * 16 + 8) = o[1];
        } else {
#pragma unroll
            for (int i = 0; i < 4; ++i) { const f32x4 gv = *(const f32x4*)(gnext + lane * 16 + 4 * i); *(f32x4*)(xr + 4 * i) = xn[i] * gv * rn; }
        }
    }
}

__device__ __forceinline__ void phase_topk_own(const float* __restrict__ ST, int* __restrict__ idx, float* __restrict__ gate, unsigned char* smem, const pg8::StaticOrder& S) {
    asm volatile("s_waitcnt vmcnt(0)" ::: "memory");
    __syncthreads();
    __builtin_amdgcn_fence(__ATOMIC_ACQUIRE, "agent");
    asm volatile("s_waitcnt vmcnt(0)" ::: "memory");
    int tid_ = threadIdx.x; asm volatile("" : "+v"(tid_));
    const int tid = tid_, lane = tid & 63, w = __builtin_amdgcn_readfirstlane(tid >> 6);
#pragma unroll 1
    for (int li = w;; li += 8) { pg8::Unit u; if (!S.next(li >> 2, u)) break;
        topk_item(ST, idx, gate, (unsigned*)smem, (u.pm * 4 + (li & 3)) * 8 + u.pn, tid, lane); }
    __syncthreads();
}
__device__ __forceinline__ void pro_s5(const float* __restrict__ lre, const float* __restrict__ lim, const float* __restrict__ bre, const float* __restrict__ bim,
                                       const float* __restrict__ cre, const float* __restrict__ cim, const float* __restrict__ lstep,
                                       bf16_t* __restrict__ Ktab, bf16_t* __restrict__ ME, bf16_t* __restrict__ MY, float* __restrict__ lam64, unsigned char* smem, int tid) {
    float2* LP = (float2*)smem;
    float2* BB = (float2*)(smem + 33280);
    float2* CC = (float2*)(smem + 33280 + 8192);
    for (int gi = blockIdx.x; gi < 256; gi += gridDim.x) {
        const int g = gi >> 2, part = gi & 3;
        __syncthreads();
        const float dt = expf(lstep[g]);
        for (int e = tid; e < 65 * 64; e += 512) {
            const int n = e >> 6, p = e & 63; const float lr = lre[g * 64 + p], li = lim[g * 64 + p];
            double rev = (double)li * (double)dt * (double)n * 0.15915494309189535; rev -= floor(rev);
            const float ang = (float)(rev * 6.283185307179586); const float mg = expf(lr * dt * (float)n);
            LP[e] = make_float2(mg * cosf(ang), mg * sinf(ang));
        }
        for (int e = tid; e < 1024; e += 512) {
            const int p = e >> 4, c = e & 15; const float lr = lre[g * 64 + p], li = lim[g * 64 + p];
            const float decay = expf(lr * dt), ar = decay * cosf(li * dt), ai = decay * sinf(li * dt), mag = lr * lr + li * li;
            const float kr = ((ar - 1.0f) * lr + ai * li) / mag, ki = (ai * lr - (ar - 1.0f) * li) / mag;
            const float br = bre[(g * 64 + p) * 16 + c], bi = bim[(g * 64 + p) * 16 + c];
            BB[e] = make_float2(kr * br - ki * bi, kr * bi + ki * br);
            const int c2 = e >> 6, p2 = e & 63;
            CC[e] = make_float2(cre[(g * 16 + c2) * 64 + p2], cim[(g * 16 + c2) * 64 + p2]);
        }
        __syncthreads();
        for (int e = tid + 512 * part; e < 65 * 256; e += 2048) {
            const int row = e >> 8, c = (e >> 4) & 15, c1 = e & 15; float s = 0.f;
            if (row > 0) { const int tau = row - 1;
                for (int p = 0; p < 64; ++p) { const float2 C = CC[c * 64 + p], L = LP[tau * 64 + p], B = BB[p * 16 + c1];
                    const float wr_ = C.x * L.x - C.y * L.y, wi_ = C.x * L.y + C.y * L.x; s += wr_ * B.x - wi_ * B.y; } }
            Ktab[(size_t)g * (65 * 256) + e] = (bf16_t)(cvt_pk_bf16(s, 0.f) & 0xffffu);
        }
        for (int e = tid + 512 * part; e < 128 * 1024; e += 2048) {
            const int row = e >> 10, k = e & 1023, ri = row >> 6, p = row & 63, j = k >> 4, c1 = k & 15;
            const float2 L = LP[(63 - j) * 64 + p], B = BB[p * 16 + c1];
            const float v = ri == 0 ? (L.x * B.x - L.y * B.y) : (L.x * B.y + L.y * B.x);
            ME[(size_t)g * (128 * 1024) + ((((row >> 5) * 64 + j) * 64 + (row & 31) + 32 * ((k >> 3) & 1)) << 3) + (k & 7)] = (bf16_t)(cvt_pk_bf16(v, 0.f) & 0xffffu);
        }
        for (int e = tid + 512 * part; e < 1024 * 128; e += 2048) {
            const int row = e >> 7, k = e & 127, t = row >> 4, c = row & 15, ri = k >> 6, p = k & 63;
            const float2 C = CC[c * 64 + p], L = LP[(t + 1) * 64 + p];
            const float v = ri == 0 ? (C.x * L.x - C.y * L.y) : -(C.x * L.y + C.y * L.x);
            MY[(size_t)g * (1024 * 128) + ((((row >> 5) * 8 + (k >> 4)) * 64 + (row & 31) + 32 * ((k >> 3) & 1)) << 3) + (k & 7)] = (bf16_t)(cvt_pk_bf16(v, 0.f) & 0xffffu);
        }
        if (tid < 64 && part == 0) { const float2 L = LP[64 * 64 + tid]; lam64[(g * 64 + tid) * 2] = L.x; lam64[(g * 64 + tid) * 2 + 1] = L.y; }
    }
}

__device__ __forceinline__ void phase_s5(const bf16_t* __restrict__ HN, const bf16_t* __restrict__ Ktab, const bf16_t* __restrict__ ME, const bf16_t* __restrict__ MY,
                                         const float* __restrict__ lam64, const float* __restrict__ s5d, bf16_t* __restrict__ GBUF, unsigned char* smem, int mode) {
    bf16_t* Ks = (bf16_t*)smem;
    unsigned char* Us = smem + 33280;
    float* Es = (float*)(smem + 33280 + 66560);
    bf16_t* Ss = (bf16_t*)(smem + 33280 + 66560 + 32768);
    const int w = __builtin_amdgcn_readfirstlane(threadIdx.x >> 6);
    int curg = -1;
    for (int it = blockIdx.x * 4; it < 1024; it += gridDim.x * 4)
        for (int k4 = 0; k4 < 4; ++k4) {
            int tid_ = threadIdx.x; asm volatile("" : "+v"(tid_));
            const int tid = tid_, lane = tid & 63, r = lane & 31, half = lane >> 5;
            const int item = it + k4, g = item >> 4, b = item & 15;
            __syncthreads();
            if (g != curg) { for (int e = tid; e < 2080; e += 512) *(u32x4*)(Ks + e * 8) = *(const u32x4*)(Ktab + (size_t)g * (65 * 256) + e * 8); curg = g; }
#pragma unroll
            for (int i = 0; i < 4; ++i) { const int tk = tid + 512 * i; const bf16_t* src = HN + (((size_t)b * 64 + g) * SEQ + tk) * 16;
                const u32x4 a = *(const u32x4*)src, c = *(const u32x4*)(src + 8); unsigned char* dst = Us + (tk >> 6) * 2080 + (tk & 63) * 32; *(u32x4*)dst = a; *(u32x4*)(dst + 16) = c; }
            __syncthreads();
            if (mode == 1) continue;
            {
                f32x16 acc;
#pragma unroll
                for (int i = 0; i < 16; ++i) acc[i] = 0.f;
                const int rb = w & 3, jh = w >> 2;
                const bf16_t* mp = ME + (size_t)g * (128 * 1024) + (size_t)((rb * 64 + 32 * jh) * 64 + lane) * 8;
                const unsigned char* up = Us + r * 2080 + 16 * half + 1024 * jh;
#pragma unroll 16
                for (int j = 0; j < 32; ++j) { const bf16x8 a = *(const bf16x8*)(mp + 512 * j); const bf16x8 bq = *(const bf16x8*)(up + j * 32); acc = MFMA32(a, bq, acc); }
#pragma unroll
                for (int i = 0; i < 16; ++i) Es[jh * 4096 + r * 128 + 32 * rb + (i & 3) + 8 * (i >> 2) + 4 * half] = acc[i];
            }
            __syncthreads();
            if (tid < 64) {
                const float lr = lam64[(g * 64 + tid) * 2], li = lam64[(g * 64 + tid) * 2 + 1]; float sr = 0.f, si = 0.f;
                float er[32], ei[32];
#pragma unroll
                for (int n = 0; n < 32; ++n) { er[n] = Es[n * 128 + tid] + Es[4096 + n * 128 + tid]; ei[n] = Es[n * 128 + 64 + tid] + Es[4096 + n * 128 + 64 + tid]; }
#pragma unroll
                for (int n = 0; n < 32; ++n) {
                    Ss[n * 136 + tid] = (bf16_t)(cvt_pk_bf16(sr, 0.f) & 0xffffu); Ss[n * 136 + 64 + tid] = (bf16_t)(cvt_pk_bf16(si, 0.f) & 0xffffu);
                    const float nr = lr * sr - li * si + er[n], ni = lr * si + li * sr + ei[n]; sr = nr; si = ni;
                }
            }
            __syncthreads();
            if (mode == 2) continue;
            f32x16 acc[4];
#pragma unroll
            for (int q = 0; q < 4; ++q)
#pragma unroll
                for (int i = 0; i < 16; ++i) acc[q][i] = 0.f;
            {
                const unsigned char* up = Us + r * 2080 + 16 * half;
                const bf16_t* kp = Ks + r * 16 + 8 * half;
                bf16x8 mya[4][4], myb[4][4];
#pragma unroll
                for (int ks = 0; ks < 4; ++ks)
#pragma unroll
                    for (int q = 0; q < 4; ++q) mya[ks][q] = *(const bf16x8*)(MY + (size_t)g * (1024 * 128) + (size_t)(((w + 8 * q) * 8 + ks) * 64 + lane) * 8);
#pragma unroll 2
                for (int j = 0; j < 64; ++j) {
                    const bf16x8 bq = *(const bf16x8*)(up + j * 32);
#pragma unroll
                    for (int q = 0; q < 4; ++q) { const int tbk = w + 8 * q; if (2 * tbk + 1 >= j) { const int d = 2 * tbk - j; const bf16x8 a = *(const bf16x8*)(kp + (d + 1) * 256); acc[q] = MFMA32(a, bq, acc[q]); } }
                }
#pragma unroll
                for (int ks = 0; ks < 4; ++ks)
#pragma unroll
                    for (int q = 0; q < 4; ++q) myb[ks][q] = *(const bf16x8*)(MY + (size_t)g * (1024 * 128) + (size_t)(((w + 8 * q) * 8 + 4 + ks) * 64 + lane) * 8);
                const bf16_t* sp = Ss + r * 136 + 8 * half;
#pragma unroll
                for (int ks = 0; ks < 4; ++ks) { const bf16x8 bq = *(const bf16x8*)(sp + 16 * ks);
#pragma unroll
                    for (int q = 0; q < 4; ++q) acc[q] = MFMA32(mya[ks][q], bq, acc[q]); }
#pragma unroll
                for (int ks = 0; ks < 4; ++ks) { const bf16x8 bq = *(const bf16x8*)(sp + 16 * (4 + ks));
#pragma unroll
                    for (int q = 0; q < 4; ++q) acc[q] = MFMA32(myb[ks][q], bq, acc[q]); }
            }
            if (mode == 3) { asm volatile("" :: "v"(acc[0][0]), "v"(acc[1][5]), "v"(acc[2][9]), "v"(acc[3][15])); continue; }
            __syncthreads();
#pragma unroll
            for (int q = 0; q < 4; ++q) {
                const int tbk = w + 8 * q;
#pragma unroll
                for (int gi = 0; gi < 4; ++gi) {
                    const int tl = 2 * tbk + (gi >> 1), cb = 8 * (gi & 1) + 4 * half;
                    unsigned char* lp_ = Us + r * 2080 + tl * 32 + cb * 2;
                    const u32x2 hv = *(const u32x2*)lp_;
                    const f32x4 dv = *(const f32x4*)(s5d + g * 16 + cb);
                    const float y0 = acc[q][4 * gi] + dv[0] * bf_lo(hv.x), y1 = acc[q][4 * gi + 1] + dv[1] * bf_hi(hv.x), y2 = acc[q][4 * gi + 2] + dv[2] * bf_lo(hv.y), y3 = acc[q][4 * gi + 3] + dv[3] * bf_hi(hv.y);
                    u32x2 o; o.x = cvt_pk_bf16(gelu_t(y0), gelu_t(y1)); o.y = cvt_pk_bf16(gelu_t(y2), gelu_t(y3));
                    *(u32x2*)lp_ = o;
                }
            }
            __syncthreads();
#pragma unroll
            for (int i = 0; i < 4; ++i) { const int tk = tid + 512 * i; bf16_t* dst = GBUF + ((size_t)b * SEQ + tk) * DM + g * 16;
                const unsigned char* src = Us + (tk >> 6) * 2080 + (tk & 63) * 32; *(u32x4*)dst = *(const u32x4*)src; *(u32x4*)(dst + 8) = *(const u32x4*)(src + 16); }
        }
}

struct EpiGlu {
    const bf16_t* GB; const float* bias; float* x; bf16_t* XB; float* sumsq; bool dry;
    static constexpr bool PERM = false, AFTER_DRAIN = false;
    __device__ __forceinline__ void operator()(const acc_t& acc, const pg8::Unit& u, int wr, int wc, int fr_, int fq_) const {
        const int pm = u.pm, pn = u.pn; int fr = fr_, fq = fq_; asm volatile("" : "+v"(fr), "+v"(fq));
#pragma unroll
        for (int ai = 0; ai < 2; ++ai) {
            u32x2 xr2[4][2][2], gr2[4][2][2];
#pragma unroll
            for (int m = 0; m < 4; ++m)
#pragma unroll
                for (int bj = 0; bj < 2; ++bj)
#pragma unroll
                    for (int n = 0; n < 2; ++n) { const size_t off = (size_t)(pm * 256 + ai * 128 + wr * 64 + m * 16 + fr) * DM + pn * 256 + bj * 128 + wc * 32 + n * 16 + fq * 4;
                        xr2[m][bj][n] = *(const u32x2*)((const bf16_t*)x + off); gr2[m][bj][n] = *(const u32x2*)(GB + off); }
#pragma unroll
            for (int m = 0; m < 4; ++m) {
                const int t = pm * 256 + ai * 128 + wr * 64 + m * 16 + fr; float ss = 0.f;
#pragma unroll
                for (int bj = 0; bj < 2; ++bj)
#pragma unroll
                    for (int n = 0; n < 2; ++n) {
                        const int col = pn * 256 + bj * 128 + wc * 32 + n * 16 + fq * 4; const size_t off = (size_t)t * DM + col;
                        const u32x2 xq2 = xr2[m][bj][n], gr = gr2[m][bj][n];
                        const f32x4 xv = (f32x4){bf_lo(xq2.x), bf_hi(xq2.x), bf_lo(xq2.y), bf_hi(xq2.y)}, bv = *(const f32x4*)(bias + col);
                        const f32x4 a = acc[ai][bj][m][n] + bv; f32x4 v;
                        v[0] = xv[0] + bf_lo(gr.x) * __builtin_amdgcn_rcpf(1.0f + __expf(-a[0])); v[1] = xv[1] + bf_hi(gr.x) * __builtin_amdgcn_rcpf(1.0f + __expf(-a[1]));
                        v[2] = xv[2] + bf_lo(gr.y) * __builtin_amdgcn_rcpf(1.0f + __expf(-a[2])); v[3] = xv[3] + bf_hi(gr.y) * __builtin_amdgcn_rcpf(1.0f + __expf(-a[3]));
                        u32x2 wv; wv.x = cvt_pk_bf16(v[0], v[1]); wv.y = cvt_pk_bf16(v[2], v[3]);
                        if (!dry) *(u32x2*)(XB + off) = wv;
                        ss += (v[0] * v[0] + v[1] * v[1]) + (v[2] * v[2] + v[3] * v[3]);
                    }
                ss += __shfl_xor(ss, 16); ss += __shfl_xor(ss, 32);
                if (fq == 0 && !dry) atomicAdd(sumsq + t, ss);
            }
            __builtin_amdgcn_sched_barrier(0);
        }
    }
};
typedef float f32x2 __attribute__((ext_vector_type(2)));
__device__ __forceinline__ void pro_table8(const float* __restrict__ src, const float* __restrict__ g, unsigned char* __restrict__ T8, float* __restrict__ S, int gw, int nw, int lane) {
    for (int e = gw; e < 16384; e += nw) {
        const float* rp = src + (size_t)e * DM + lane * 16; f32x4 v[4]; float mx = 0.f;
#pragma unroll
        for (int i = 0; i < 4; ++i) { v[i] = *(const f32x4*)(rp + 4 * i); if (g) v[i] = v[i] * *(const f32x4*)(g + lane * 16 + 4 * i);
            mx = fmaxf(mx, fmaxf(fmaxf(fabsf(v[i][0]), fabsf(v[i][1])), fmaxf(fabsf(v[i][2]), fabsf(v[i][3])))); }
#pragma unroll
        for (int o = 32; o > 0; o >>= 1) mx = fmaxf(mx, __shfl_xor(mx, o));
        const float s = mx > 0.f ? mx * (1.0f / 448.0f) : 1.0f, inv = 1.0f / s;
        u32x4 q;
#pragma unroll
        for (int i = 0; i < 4; ++i) { int w = __builtin_amdgcn_cvt_pk_fp8_f32(v[i][0] * inv, v[i][1] * inv, 0, false); w = __builtin_amdgcn_cvt_pk_fp8_f32(v[i][2] * inv, v[i][3] * inv, w, true); q[i] = (unsigned)w; }
        *(u32x4*)(T8 + (size_t)e * DM + lane * 16) = q;
        if (lane == 0) S[e] = s;
    }
}

template <int MODE>
__device__ __forceinline__ void phase_expert8(const bf16_t* __restrict__ XB, const float* __restrict__ sumsq, const int* __restrict__ idx, const float* __restrict__ gate,
                                              const unsigned char* __restrict__ Ut, const unsigned char* __restrict__ Vt, const float* __restrict__ SU, const float* __restrict__ SV,
                                              float* __restrict__ x, const float* __restrict__ gnext, bf16_t* __restrict__ XBout, int gw, int nw, int lane, bool dry) {
    const int pk = ((lane >> 5) & 1) * 4 + ((lane >> 4) & 1) * 2 + ((lane >> 3) & 1);
    for (int t0 = gw; t0 < T_TOK; t0 += nw) {
        const int t = __builtin_amdgcn_readfirstlane(t0);
        const u32x4 xa = *(const u32x4*)(XB + (size_t)t * DM + lane * 16), xb = *(const u32x4*)(XB + (size_t)t * DM + lane * 16 + 8);
        const f32x2 x2[8] = {{bf_lo(xa.x), bf_hi(xa.x)}, {bf_lo(xa.y), bf_hi(xa.y)}, {bf_lo(xa.z), bf_hi(xa.z)}, {bf_lo(xa.w), bf_hi(xa.w)},
                             {bf_lo(xb.x), bf_hi(xb.x)}, {bf_lo(xb.y), bf_hi(xb.y)}, {bf_lo(xb.z), bf_hi(xb.z)}, {bf_lo(xb.w), bf_hi(xb.w)}};
        const float rs = rsqrtf(sumsq[t] * (1.0f / DM) + 1e-6f);
        f32x2 y2[8];
#pragma unroll
        for (int i = 0; i < 8; ++i) y2[i] = (f32x2){0.f, 0.f};
#pragma unroll 1
        for (int grp = 0; grp < 16; ++grp) {
            const int* ip = idx + (size_t)t * 128 + grp * 8;
            int e[8];
#pragma unroll
            for (int k = 0; k < 8; ++k) e[k] = __builtin_amdgcn_readfirstlane(ip[k]);
            u32x4 uq[8], vq[8];
#pragma unroll
            for (int k = 0; k < 8; ++k) uq[k] = *(const u32x4*)(Ut + (size_t)e[k] * DM + lane * 16);
#pragma unroll
            for (int k = 0; k < 8; ++k) vq[k] = *(const u32x4*)(Vt + (size_t)e[k] * DM + lane * 16);
            const int emy = ip[pk]; const float wsc = gate[(size_t)t * 128 + grp * 8 + pk] * SV[emy], usc = SU[emy] * rs;
            float d[8];
#pragma unroll
            for (int k = 0; k < 8; ++k) {
                f32x2 a0 = (f32x2){0.f, 0.f}, a1 = (f32x2){0.f, 0.f};
#pragma unroll
                for (int i = 0; i < 4; ++i) {
                    a0 = __builtin_elementwise_fma(__builtin_amdgcn_cvt_pk_f32_fp8((int)uq[k][i], false), x2[2 * i], a0);
                    a1 = __builtin_elementwise_fma(__builtin_amdgcn_cvt_pk_f32_fp8((int)uq[k][i], true), x2[2 * i + 1], a1);
                }
                d[k] = (a0.x + a0.y) + (a1.x + a1.y);
            }
            float r4[4], r2[2], r1;
            { const bool hi = (lane & 32) != 0;
#pragma unroll
              for (int i = 0; i < 4; ++i) { const float keep = hi ? d[i + 4] : d[i], send = hi ? d[i] : d[i + 4]; r4[i] = keep + __shfl_xor(send, 32); } }
            { const bool hi = (lane & 16) != 0;
#pragma unroll
              for (int i = 0; i < 2; ++i) { const float keep = hi ? r4[i + 2] : r4[i], send = hi ? r4[i] : r4[i + 2]; r2[i] = keep + __shfl_xor(send, 16); } }
            { const bool hi = (lane & 8) != 0; const float keep = hi ? r2[1] : r2[0], send = hi ? r2[0] : r2[1]; r1 = keep + __shfl_xor(send, 8); }
            r1 += __shfl_xor(r1, 4); r1 += __shfl_xor(r1, 2); r1 += __shfl_xor(r1, 1);
            const float wgt = wsc * gelu_t(r1 * usc);
#pragma unroll
            for (int k = 0; k < 8; ++k) {
                const float wk = __uint_as_float(__builtin_amdgcn_readlane(__float_as_uint(wgt), ((k >> 2) & 1) * 32 + ((k >> 1) & 1) * 16 + (k & 1) * 8));
                const f32x2 w2 = (f32x2){wk, wk};
#pragma unroll
                for (int i = 0; i < 4; ++i) {
                    y2[2 * i] = __builtin_elementwise_fma(__builtin_amdgcn_cvt_pk_f32_fp8((int)vq[k][i], false), w2, y2[2 * i]);
                    y2[2 * i + 1] = __builtin_elementwise_fma(__builtin_amdgcn_cvt_pk_f32_fp8((int)vq[k][i], true), w2, y2[2 * i + 1]);
                }
            }
        }
        if (dry) continue;
        float* xr = x + (size_t)t * DM + lane * 16; float ss = 0.f; f32x4 xn[4];
#pragma unroll
        for (int i = 0; i < 4; ++i) { const f32x4 xv = *(const f32x4*)(xr + 4 * i); xn[i] = xv + (f32x4){y2[2 * i].x, y2[2 * i].y, y2[2 * i + 1].x, y2[2 * i + 1].y};
            ss += (xn[i][0] * xn[i][0] + xn[i][1] * xn[i][1]) + (xn[i][2] * xn[i][2] + xn[i][3] * xn[i][3]); }
        ss = wave_sum(ss); const float rn = rsqrtf(ss * (1.0f / DM) + 1e-6f);
        if (MODE == 0) {
            u32x4 o[2];
#pragma unroll
            for (int i = 0; i < 4; ++i) { *(f32x4*)(xr + 4 * i) = xn[i]; const f32x4 gv = *(const f32x4*)(gnext + lane * 16 + 4 * i); const f32x4 r = xn[i] * gv * rn;
                const unsigned a = cvt_pk_bf16(r[0], r[1]), b = cvt_pk_bf16(r[2], r[3]);
                if ((i & 1) == 0) { o[i >> 1].x = a; o[i >> 1].y = b; } else { o[i >> 1].z = a; o[i >> 1].w = b; } }
            *(u32x4*)(XBout + (size_t)t * DM + lane * 16) = o[0]; *(u32x4*)(XBout + (size_t)t * DM + lane * 16 + 8) = o[1];
        } else {
#pragma unroll
            for (int i = 0; i < 4; ++i) { const f32x4 gv = *(const f32x4*)(gnext + lane * 16 + 4 * i); *(f32x4*)(xr + 4 * i) = xn[i] * gv * rn; }
        }
    }
}
typedef int v6i __attribute__((ext_vector_type(6)));
typedef float v32f __attribute__((ext_vector_type(32)));
typedef float v16f __attribute__((ext_vector_type(16)));
#define ROW6 768
__device__ __forceinline__ void pro_table6(const float* __restrict__ src, const float* __restrict__ g, unsigned char* __restrict__ T6, float* __restrict__ S, int gw, int nw, int lane) {
    const int lp = lane & 31, hf = lane >> 5;
    for (int e0 = gw * 4; e0 < 16384; e0 += nw * 4) {
        v16f a[2], b[2]; float mx[2];
#pragma unroll
        for (int u = 0; u < 2; ++u) {
            const float* rp = src + (size_t)(e0 + 2 * u + hf) * DM + lp * 32;
#pragma unroll
            for (int i = 0; i < 4; ++i) { const f32x4 v = *(const f32x4*)(rp + 4 * i); a[u][4 * i] = v[0]; a[u][4 * i + 1] = v[1]; a[u][4 * i + 2] = v[2]; a[u][4 * i + 3] = v[3]; }
#pragma unroll
            for (int i = 0; i < 4; ++i) { const f32x4 v = *(const f32x4*)(rp + 16 + 4 * i); b[u][4 * i] = v[0]; b[u][4 * i + 1] = v[1]; b[u][4 * i + 2] = v[2]; b[u][4 * i + 3] = v[3]; }
        }
        if (g) {
#pragma unroll
            for (int i = 0; i < 4; ++i) { const f32x4 g0 = *(const f32x4*)(g + lp * 32 + 4 * i), g1 = *(const f32x4*)(g + lp * 32 + 16 + 4 * i);
#pragma unroll
                for (int u = 0; u < 2; ++u) { a[u][4 * i] *= g0[0]; a[u][4 * i + 1] *= g0[1]; a[u][4 * i + 2] *= g0[2]; a[u][4 * i + 3] *= g0[3];
                    b[u][4 * i] *= g1[0]; b[u][4 * i + 1] *= g1[1]; b[u][4 * i + 2] *= g1[2]; b[u][4 * i + 3] *= g1[3]; } }
        }
#pragma unroll
        for (int u = 0; u < 2; ++u) { mx[u] = 0.f;
#pragma unroll
            for (int i = 0; i < 16; ++i) mx[u] = fmaxf(mx[u], fmaxf(fabsf(a[u][i]), fabsf(b[u][i]))); }
#pragma unroll
        for (int o = 16; o > 0; o >>= 1) { mx[0] = fmaxf(mx[0], __shfl_xor(mx[0], o)); mx[1] = fmaxf(mx[1], __shfl_xor(mx[1], o)); }
#pragma unroll
        for (int u = 0; u < 2; ++u) {
            const int e = e0 + 2 * u + hf;
            const float s = mx[u] > 0.f ? mx[u] * (1.0f / 7.5f) : 1.0f, inv = 1.0f / s;
            v16f ev, od;
#pragma unroll
            for (int i = 0; i < 8; ++i) { ev[i] = a[u][2 * i] * inv; od[i] = a[u][2 * i + 1] * inv; ev[8 + i] = b[u][2 * i] * inv; od[8 + i] = b[u][2 * i + 1] * inv; }
            const v6i q = __builtin_amdgcn_cvt_scalef32_2xpk16_fp6_f32(ev, od, 1.0f);
            unsigned char* row = T6 + (size_t)e * ROW6;
            *(u32x4*)(row + 16 * lp) = (u32x4){(unsigned)q[0], (unsigned)q[1], (unsigned)q[2], (unsigned)q[3]};
            *(u32x2*)(row + 512 + 8 * lp) = (u32x2){(unsigned)q[4], (unsigned)q[5]};
            if (lp == 0) S[e] = s;
        }
    }
}

template <int MODE>
__device__ __forceinline__ void phase_expert6(const bf16_t* __restrict__ XB, const float* __restrict__ sumsq, const int* __restrict__ idx, const float* __restrict__ gate,
                                              const unsigned char* __restrict__ Ut, const unsigned char* __restrict__ Vt, const float* __restrict__ SU, const float* __restrict__ SV,
                                              float* __restrict__ x, const float* __restrict__ gnext, bf16_t* __restrict__ XBout, int gw, int nw, int lane__, bool dry) {
    const int lane = lane__;
    for (int t0 = gw; t0 < T_TOK; t0 += nw) {
        int lane_ = lane; asm volatile("" : "+v"(lane_));
        const int lane = lane_, lp = lane & 31, hf = lane >> 5;
        const int myslot = ((lane >> 4) & 1) * 2 + ((lane >> 3) & 1);
        const int t = __builtin_amdgcn_readfirstlane(t0);
        float xf[32];
        { const bf16_t* xp = XB + (size_t)t * DM + lp * 32;
#pragma unroll
          for (int i = 0; i < 4; ++i) { const u32x4 r = *(const u32x4*)(xp + 8 * i);
              xf[8 * i] = bf_lo(r.x); xf[8 * i + 1] = bf_hi(r.x); xf[8 * i + 2] = bf_lo(r.y); xf[8 * i + 3] = bf_hi(r.y);
              xf[8 * i + 4] = bf_lo(r.z); xf[8 * i + 5] = bf_hi(r.z); xf[8 * i + 6] = bf_lo(r.w); xf[8 * i + 7] = bf_hi(r.w); } }
        const float rs = rsqrtf(sumsq[t] * (1.0f / DM) + 1e-6f);
        float y[32];
#pragma unroll
        for (int i = 0; i < 32; ++i) y[i] = 0.f;
#pragma unroll 1
        for (int grp = 0; grp < 16; ++grp) {
            const int* ip = idx + (size_t)t * 128 + grp * 8;
            u32x4 u4[4], v4[4]; u32x2 u2[4], v2[4];
#pragma unroll
            for (int k = 0; k < 4; ++k) { const int e = ip[2 * k + hf]; const unsigned char* ur = Ut + (size_t)e * ROW6; u4[k] = *(const u32x4*)(ur + 16 * lp); u2[k] = *(const u32x2*)(ur + 512 + 8 * lp); }
#pragma unroll
            for (int k = 0; k < 4; ++k) { const int e = ip[2 * k + hf]; const unsigned char* vr = Vt + (size_t)e * ROW6; v4[k] = *(const u32x4*)(vr + 16 * lp); v2[k] = *(const u32x2*)(vr + 512 + 8 * lp); }
            const int mypick = 2 * myslot + hf; const int emy = ip[mypick];
            const float wsc = gate[(size_t)t * 128 + grp * 8 + mypick] * SV[emy], usc = SU[emy] * rs;
            float d[4];
#pragma unroll
            for (int k = 0; k < 4; ++k) {
                const v6i w = {(int)u4[k].x, (int)u4[k].y, (int)u4[k].z, (int)u4[k].w, (int)u2[k].x, (int)u2[k].y};
                const v32f r = __builtin_amdgcn_cvt_scalef32_pk32_f32_fp6(w, 1.0f);
                float s0 = 0.f, s1 = 0.f, s2 = 0.f, s3 = 0.f;
#pragma unroll
                for (int i = 0; i < 8; ++i) { s0 += r[4 * i] * xf[4 * i]; s1 += r[4 * i + 1] * xf[4 * i + 1]; s2 += r[4 * i + 2] * xf[4 * i + 2]; s3 += r[4 * i + 3] * xf[4 * i + 3]; }
                d[k] = (s0 + s1) + (s2 + s3);
            }
            float r2[2], r1;
            { const bool hi = (lane & 16) != 0;
#pragma unroll
              for (int i = 0; i < 2; ++i) { const float keep = hi ? d[i + 2] : d[i], send = hi ? d[i] : d[i + 2]; r2[i] = keep + __shfl_xor(send, 16); } }
            { const bool hi = (lane & 8) != 0; const float keep = hi ? r2[1] : r2[0], send = hi ? r2[0] : r2[1]; r1 = keep + __shfl_xor(send, 8); }
            r1 += __shfl_xor(r1, 4); r1 += __shfl_xor(r1, 2); r1 += __shfl_xor(r1, 1);
            const float wgt = wsc * gelu_t(r1 * usc);
#pragma unroll
            for (int k = 0; k < 4; ++k) {
                const int sl = ((k >> 1) & 1) * 16 + (k & 1) * 8;
                const float wlo = __uint_as_float(__builtin_amdgcn_readlane(__float_as_uint(wgt), sl)), whi = __uint_as_float(__builtin_amdgcn_readlane(__float_as_uint(wgt), 32 + sl));
                const float wk = hf ? whi : wlo;
                const v6i w = {(int)v4[k].x, (int)v4[k].y, (int)v4[k].z, (int)v4[k].w, (int)v2[k].x, (int)v2[k].y};
                const v32f r = __builtin_amdgcn_cvt_scalef32_pk32_f32_fp6(w, 1.0f);
#pragma unroll
                for (int i = 0; i < 32; ++i) y[i] += wk * r[i];
            }
        }
        float yo[16];
#pragma unroll
        for (int i = 0; i < 16; ++i) { const float mine = hf ? y[16 + i] : y[i], other = hf ? y[i] : y[16 + i]; yo[i] = mine + __shfl_xor(other, 32); }
        if (dry) continue;
        float* xr = x + (size_t)t * DM + lp * 32 + hf * 16; float ss = 0.f; f32x4 xn[4];
#pragma unroll
        for (int i = 0; i < 4; ++i) { const f32x4 xv = *(const f32x4*)(xr + 4 * i); xn[i] = xv + (f32x4){yo[4 * i], yo[4 * i + 1], yo[4 * i + 2], yo[4 * i + 3]};
            ss += (xn[i][0] * xn[i][0] + xn[i][1] * xn[i][1]) + (xn[i][2] * xn[i][2] + xn[i][3] * xn[i][3]); }
        ss = wave_sum(ss); const float rn = rsqrtf(ss * (1.0f / DM) + 1e-6f);
        const float* gp = gnext + lp * 32 + hf * 16;
        if (MODE == 0) {
            u32x4 o[2];
#pragma unroll
            for (int i = 0; i < 4; ++i) { *(f32x4*)(xr + 4 * i) = xn[i]; const f32x4 gv = *(const f32x4*)(gp + 4 * i); const f32x4 r = xn[i] * gv * rn;
                const unsigned a = cvt_pk_bf16(r[0], r[1]), b = cvt_pk_bf16(r[2], r[3]);
                if ((i & 1) == 0) { o[i >> 1].x = a; o[i >> 1].y = b; } else { o[i >> 1].z = a; o[i >> 1].w = b; } }
            bf16_t* xo = XBout + (size_t)t * DM + lp * 32 + hf * 16;
            *(u32x4*)xo = o[0]; *(u32x4*)(xo + 8) = o[1];
        } else {
#pragma unroll
            for (int i = 0; i < 4; ++i) { const f32x4 gv = *(const f32x4*)(gp + 4 * i); *(f32x4*)(xr + 4 * i) = xn[i] * gv * rn; }
        }
    }
}
#define EXP_RING_BYTES 18432
__device__ __forceinline__ int laneid_opaque() { int z = 0; asm volatile("" : "+v"(z)); return (int)__builtin_amdgcn_mbcnt_hi(~0u, __builtin_amdgcn_mbcnt_lo(~0u, (unsigned)z)); }
typedef unsigned v16u __attribute__((ext_vector_type(16)));
typedef __bf16 v32bf __attribute__((ext_vector_type(32)));
typedef _Float16 v32h __attribute__((ext_vector_type(32)));
typedef _Float16 h2 __attribute__((ext_vector_type(2)));
template <int MODE>
__device__ __forceinline__ void phase_expert6d(const bf16_t* __restrict__ XB, const float* __restrict__ sumsq, const int* __restrict__ idx, const float* __restrict__ gate,
                                               const unsigned char* __restrict__ Ut, const unsigned char* __restrict__ Vt, const float* __restrict__ SU, const float* __restrict__ SV,
                                               float* __restrict__ x, const float* __restrict__ gnext, bf16_t* __restrict__ XBout, unsigned char* smem, int nblk, bool dry, int emode) {
    const int wid = __builtin_amdgcn_readfirstlane(threadIdx.x >> 6), gw = blockIdx.x * 8 + wid, nw = nblk * 8;
    LAS unsigned char* RB = (LAS unsigned char*)smem + wid * EXP_RING_BYTES;
    for (int pr = gw; pr < T_TOK / 2; pr += nw) {
        const int lane = laneid_opaque(), lp = lane & 31, hf = lane >> 5;
        const int myslot = ((lane >> 4) & 1) * 2 + ((lane >> 3) & 1);
        const int t = 2 * pr + hf;
        unsigned key[4];
#pragma unroll
        for (int q = 0; q < 4; ++q) { const int pk = 32 * q + lp; key[q] = ((unsigned)idx[(size_t)t * 128 + pk] << 7) | (unsigned)pk; }
        unsigned xq[16];
        { const bf16_t* xp = XB + (size_t)t * DM + lp * 32;
#pragma unroll
          for (int i = 0; i < 4; ++i) { const u32x4 r = *(const u32x4*)(xp + 8 * i); xq[4 * i] = r.x; xq[4 * i + 1] = r.y; xq[4 * i + 2] = r.z; xq[4 * i + 3] = r.w; } }
        const float rs = rsqrtf(sumsq[t] * (1.0f / DM) + 1e-6f);
#pragma unroll
        for (int k = 2; k <= 128; k <<= 1)
#pragma unroll
            for (int j = k >> 1; j >= 1; j >>= 1) {
                if (j >= 32) {
                    const int dq = j >> 5;
#pragma unroll
                    for (int q = 0; q < 4; ++q) if ((q & dq) == 0) {
                        const bool asc = k == 128 ? true : (((32 * q) & k) == 0);
                        const unsigned lo = min(key[q], key[q | dq]), hi = max(key[q], key[q | dq]);
                        key[q] = asc ? lo : hi; key[q | dq] = asc ? hi : lo;
                    }
                } else {
#pragma unroll
                    for (int q = 0; q < 4; ++q) {
                        unsigned other;
                        if (j == 1) other = (unsigned)__builtin_amdgcn_update_dpp(0, (int)key[q], 0xB1, 0xf, 0xf, true);
                        else if (j == 2) other = (unsigned)__builtin_amdgcn_update_dpp(0, (int)key[q], 0x4E, 0xf, 0xf, true);
                        else if (j == 4) other = (unsigned)__builtin_amdgcn_update_dpp(0, __builtin_amdgcn_update_dpp(0, (int)key[q], 0x141  , 0xf, 0xf, true), 0x1B  , 0xf, 0xf, true);
                        else if (j == 8) other = (unsigned)__builtin_amdgcn_update_dpp(0, (int)key[q], 0x128, 0xf, 0xf, true);
                        else { const auto sw = __builtin_amdgcn_permlane16_swap(key[q], key[q], false, false); other = (lane & 16) ? sw[0] : sw[1]; }
                        const int s = 32 * q + lp; const bool asc = (s & k) == 0, lower = (lp & j) == 0;
                        const unsigned lo = min(key[q], other), hi = max(key[q], other);
                        key[q] = (asc == lower) ? lo : hi;
                    }
                }
            }
        int ide[4];
        LAS unsigned* MT = (LAS unsigned*)((LAS unsigned char*)smem + 8 * EXP_RING_BYTES + wid * 1024) + hf * 128;
#pragma unroll
        for (int q = 0; q < 4; ++q) { ide[q] = (int)(key[q] >> 7); const int pk = (int)(key[q] & 127u);
            MT[32 * q + lp] = cvt_pk_bf16(SU[ide[q]] * rs, gate[(size_t)t * 128 + pk] * SV[ide[q]]); }
        h2 yh[16];
#pragma unroll
        for (int i = 0; i < 16; ++i) yh[i] = (h2){(_Float16)0.f, (_Float16)0.f};
        asm volatile("s_waitcnt vmcnt(0)" ::: "memory");
        int pl_[6], po_[6];
#pragma unroll
        for (int _i = 0; _i < 6; ++_i) { const int _byte = 1024 * _i + 16 * lane, _r = (_byte * 683) >> 19; po_[_i] = _byte - 768 * _r; pl_[_i] = 32 * (_r & 1) + (_r >> 1); }
        int ido[4];
#pragma unroll
        for (int q = 0; q < 4; ++q) ido[q] = ide[q] * ROW6;
#define EXP_ADDR(A, HG) do { const int _g = (HG) >> 1; const int _idr = (_g < 8) ? ido[0] : ((_g < 16) ? ido[1] : ((_g < 24) ? ido[2] : ido[3])); \
            _Pragma("unroll") for (int _i = 0; _i < 6; ++_i) A[_i] = __shfl(_idr, (pl_[_i] & 32) + ((4 * _g + pl_[_i]) & 31)) + po_[_i]; } while (0)
#define EXP_DMA(A, HG) do { const int _hg = (HG); const unsigned char* _tab = (_hg & 1) ? Vt : Ut; LAS unsigned char* _dst = RB + (_hg % 3) * 6144; \
            _Pragma("unroll") for (int _i = 0; _i < 6; ++_i) __builtin_amdgcn_global_load_lds((const unsigned*)(_tab + (unsigned)A[_i]), (LAS unsigned*)(_dst + 1024 * _i), 16, 0, 0); } while (0)
#define EXP_ISSUE(HG) do { int _a[6]; EXP_ADDR(_a, HG); EXP_DMA(_a, HG); } while (0)
        { int a0_[6], a1_[6]; EXP_ADDR(a0_, 0); EXP_ADDR(a1_, 1); EXP_DMA(a0_, 0); EXP_DMA(a1_, 1); }
#pragma unroll 1
        for (int g = 0; g < 32; ++g) {
            if (g < 31) { EXP_ISSUE(2 * g + 2); asm volatile("s_waitcnt vmcnt(12)" ::: "memory"); } else { asm volatile("s_waitcnt vmcnt(6)" ::: "memory"); }
            float wgt;
            {
                const LAS unsigned char* bu = RB + ((2 * g) % 3) * 6144 + hf * 768 + 16 * lp;
                float d[4] = {0.f, 0.f, 0.f, 0.f};
                if (emode < 2)
#pragma unroll
                for (int k = 0; k < 4; ++k) {
                    const u32x4 q4 = *(const LAS u32x4*)(bu + k * 1536); const u32x2 q2 = *(const LAS u32x2*)(bu + k * 1536 + 512 - 8 * lp);
                    const v6i w = {(int)q4.x, (int)q4.y, (int)q4.z, (int)q4.w, (int)q2.x, (int)q2.y};
                    const v16u r = __builtin_bit_cast(v16u, __builtin_amdgcn_cvt_scalef32_pk32_bf16_fp6(w, 1.0f));
                    float s0 = 0.f, s1 = 0.f, s2 = 0.f, s3 = 0.f;
#pragma unroll
                    for (int i = 0; i < 4; ++i) { s0 = dot2bf(r[4 * i], xq[4 * i], s0); s1 = dot2bf(r[4 * i + 1], xq[4 * i + 1], s1); s2 = dot2bf(r[4 * i + 2], xq[4 * i + 2], s2); s3 = dot2bf(r[4 * i + 3], xq[4 * i + 3], s3); }
                    d[k] = (s0 + s1) + (s2 + s3);
                }
                float r2[2], r1;
#pragma unroll
                for (int i = 0; i < 2; ++i) { const auto sw = __builtin_amdgcn_permlane16_swap(__float_as_uint(d[i]), __float_as_uint(d[i + 2]), false, false); r2[i] = __uint_as_float(sw[0]) + __uint_as_float(sw[1]); }
                { const bool hi = (lane & 8) != 0; const float keep = hi ? r2[1] : r2[0], send = hi ? r2[0] : r2[1];
                  r1 = keep + __uint_as_float((unsigned)__builtin_amdgcn_update_dpp(0, (int)__float_as_uint(send), 0x128  , 0xf, 0xf, true)); }
                r1 += __uint_as_float((unsigned)__builtin_amdgcn_update_dpp(0, (int)__float_as_uint(r1), 0x141  , 0xf, 0xf, true));
                r1 += __uint_as_float((unsigned)__builtin_amdgcn_update_dpp(0, (int)__float_as_uint(r1), 0x4E  , 0xf, 0xf, true));
                r1 += __uint_as_float((unsigned)__builtin_amdgcn_update_dpp(0, (int)__float_as_uint(r1), 0xB1  , 0xf, 0xf, true));
                const unsigned mt = MT[4 * g + myslot];
                wgt = bf_hi(mt) * gelu_t(r1 * bf_lo(mt));
            }
            if (g < 31) { EXP_ISSUE(2 * g + 3); asm volatile("s_waitcnt vmcnt(12)" ::: "memory"); } else { asm volatile("s_waitcnt vmcnt(0)" ::: "memory"); }
            {
                const LAS unsigned char* bv = RB + ((2 * g + 1) % 3) * 6144 + hf * 768 + 16 * lp;
                if (emode < 1)
#pragma unroll
                for (int k = 0; k < 4; ++k) {
                    const int sl = ((k >> 1) & 1) * 16 + (k & 1) * 8;
                    const float wlo = __uint_as_float(__builtin_amdgcn_readlane(__float_as_uint(wgt), sl)), whi = __uint_as_float(__builtin_amdgcn_readlane(__float_as_uint(wgt), 32 + sl));
                    const float wk = hf ? whi : wlo;
                    const u32x4 q4 = *(const LAS u32x4*)(bv + k * 1536); const u32x2 q2 = *(const LAS u32x2*)(bv + k * 1536 + 512 - 8 * lp);
                    const v6i w = {(int)q4.x, (int)q4.y, (int)q4.z, (int)q4.w, (int)q2.x, (int)q2.y};
                    const v32h r = __builtin_amdgcn_cvt_scalef32_pk32_f16_fp6(w, 1.0f);
                    const h2 w2 = (h2){(_Float16)wk, (_Float16)wk};
#pragma unroll
                    for (int i = 0; i < 16; ++i) yh[i] = __builtin_elementwise_fma((h2){r[2 * i], r[2 * i + 1]}, w2, yh[i]);
                }
            }
        }
#undef EXP_ISSUE
#undef EXP_ADDR
#undef EXP_DMA
        if (dry) continue;
        float y[32];
#pragma unroll
        for (int i = 0; i < 16; ++i) { y[2 * i] = (float)yh[i].x; y[2 * i + 1] = (float)yh[i].y; }
        float* xr = x + (size_t)t * DM + lp * 32; float ss = 0.f;
#pragma unroll
        for (int i = 0; i < 8; ++i) { y[4 * i] += bf_lo(xq[2 * i]); y[4 * i + 1] += bf_hi(xq[2 * i]); y[4 * i + 2] += bf_lo(xq[2 * i + 1]); y[4 * i + 3] += bf_hi(xq[2 * i + 1]);
            ss += (y[4 * i] * y[4 * i] + y[4 * i + 1] * y[4 * i + 1]) + (y[4 * i + 2] * y[4 * i + 2] + y[4 * i + 3] * y[4 * i + 3]); }
#pragma unroll
        for (int o = 16; o > 0; o >>= 1) ss += __shfl_xor(ss, o);
        const float rn = rsqrtf(ss * (1.0f / DM) + 1e-6f);
        const float* gp = gnext + lp * 32;
        if (MODE == 0) {
            bf16_t* xo = XBout + (((size_t)(t >> 11) * 64 + 2 * lp) * SEQ + (t & 2047)) * 16;
#pragma unroll
            for (int i = 0; i < 4; ++i) {
                { u32x4 xr16; xr16.x = cvt_pk_bf16(y[8 * i], y[8 * i + 1]); xr16.y = cvt_pk_bf16(y[8 * i + 2], y[8 * i + 3]); xr16.z = cvt_pk_bf16(y[8 * i + 4], y[8 * i + 5]); xr16.w = cvt_pk_bf16(y[8 * i + 6], y[8 * i + 7]);
                  *(u32x4*)((bf16_t*)x + (size_t)t * DM + lp * 32 + 8 * i) = xr16; }
                const f32x4 g0 = *(const f32x4*)(gp + 8 * i), g1 = *(const f32x4*)(gp + 8 * i + 4);
                u32x4 o; o.x = cvt_pk_bf16(y[8 * i] * g0[0] * rn, y[8 * i + 1] * g0[1] * rn); o.y = cvt_pk_bf16(y[8 * i + 2] * g0[2] * rn, y[8 * i + 3] * g0[3] * rn);
                o.z = cvt_pk_bf16(y[8 * i + 4] * g1[0] * rn, y[8 * i + 5] * g1[1] * rn); o.w = cvt_pk_bf16(y[8 * i + 6] * g1[2] * rn, y[8 * i + 7] * g1[3] * rn);
                *(u32x4*)(xo + (size_t)(i >> 1) * (SEQ * 16) + 8 * (i & 1)) = o;
            }
        } else {
#pragma unroll
            for (int i = 0; i < 8; ++i) { const f32x4 gv = *(const f32x4*)(gp + 4 * i); *(f32x4*)(xr + 4 * i) = (f32x4){y[4 * i] * gv[0] * rn, y[4 * i + 1] * gv[1] * rn, y[4 * i + 2] * gv[2] * rn, y[4 * i + 3] * gv[3] * rn}; }
        }
    }
}
typedef const __attribute__((address_space(4))) P* PK;
#define LDS_XST (147456 + 8192)
#define LDS_TOTAL (147456 + 8192 + 16)
__global__ void __launch_bounds__(512) mega(P p_) {
#if defined(__HIP_DEVICE_COMPILE__)
    extern __shared__ __attribute__((aligned(16))) unsigned char smem[];
    cg::grid_group grid = cg::this_grid();
    const int ph_lo = p_.ph_lo, ph_hi = p_.ph_hi;
    volatile LAS unsigned* xst = (volatile LAS unsigned*)(smem + LDS_XST);
    if (threadIdx.x == 0) { xst[0] = 0u; xst[1] = 0u; }
    __syncthreads();
    const XcdBarrier xb = xcd_barrier_post((unsigned*)(p_.ws + WS_BAR), xst);
    const int rep_ph = p_.rep_ph, rep_n = p_.rep_n;
#ifndef PROBE_REPLAY_K
#define PROBE_REPLAY_K -1
#endif
    for (int pass = 0; pass < (PROBE_REPLAY_K >= 0 ? 2 : 1); ++pass)
    for (int ph = ph_lo; ph <= (pass == 0 ? ph_hi : PROBE_REPLAY_K); ++ph) {
        if (ph == 5 || ph == 10) continue;
#if PROBE_REP_N > 1
        const int reps = (ph == rep_ph && rep_n > 1) ? rep_n : 1;
        for (int rep = 0; rep < reps; ++rep) {
        const bool dry = rep > 0;
#else
        {
        const bool dry = PROBE_REPLAY_K >= 0 ? (pass > 0) : false;
#endif
        const int ph_outer = ph; int ph = ph_outer; asm volatile("" : "+s"(ph));
        PK pk = (PK)__builtin_amdgcn_kernarg_segment_ptr(); asm volatile("" : "+s"(pk));
        const P p = *pk;
        unsigned char* ws = p.ws;
        bf16_t* XB = (bf16_t*)(ws + WS_XB);
        int nb_ = gridDim.x; asm volatile("" : "+s"(nb_));
#define PH_IDS int tid_ = threadIdx.x; asm volatile("" : "+v"(tid_)); const int tid = tid_, lane = tid & 63, gw = blockIdx.x * 8 + (tid >> 6), nw = nb_ * 8, gtid = blockIdx.x * 512 + tid, nthr = nb_ * 512; (void)lane; (void)gw; (void)nw; (void)gtid; (void)nthr;
        if (ph == 0) { PH_IDS
            const int pm0 = dry ? PROBE_S5_MODE : 0;
            if (pm0 == 0) {
                const int wv = tid >> 6, nblk_ = nb_;
                if (wv < 4) {
                    const int rgw = blockIdx.x * 4 + wv, rnw = nblk_ * 4;
                    for (int l = 0; l < 2; ++l) {
                        pro_table6(p.pu + (size_t)l * 16384 * 1024, p.norm_ffn_g + l * DM, ws + WS_UTAB + MB(12) * l, (float*)(ws + WS_SU) + l * 16384, rgw, rnw, lane);
                        pro_table6(p.pv + (size_t)l * 16384 * 1024, nullptr, ws + WS_VTAB + MB(12) * l, (float*)(ws + WS_SV) + l * 16384, rgw, rnw, lane);
                    }
                } else if (wv < 7) {
                    pro_rmsnorm_rows(p.x, p.norm_mix_g, XB, blockIdx.x * 3 + (wv - 4), nblk_ * 3, lane);
                } else {
                    const int rt = blockIdx.x * 64 + lane, rn = nblk_ * 64;
                    pro_transpose<true>(p.w_in, 2560, nullptr, (bf16_t*)(ws + WS_WTIN), rt, rn);
                    pro_transpose<false>(p.w_out, 1024, nullptr, (bf16_t*)(ws + WS_WTOUT), rt, rn);
                    pro_transpose<false>(p.glu_w, 1024, nullptr, (bf16_t*)(ws + WS_WTGLU), rt, rn);
                }
                pro_wqk(p.wq, p.subkeys, p.norm_ffn_g, (bf16_t*)(ws + WS_WQK), gw, nw, lane);
            }
            if (pm0 == 1) {
            pro_rmsnorm_rows(p.x, p.norm_mix_g, XB, gw, nw, lane);
            pro_transpose<true>(p.w_in, 2560, nullptr, (bf16_t*)(ws + WS_WTIN), gtid, nthr);
            pro_transpose<false>(p.w_out, 1024, nullptr, (bf16_t*)(ws + WS_WTOUT), gtid, nthr);
            pro_wqk(p.wq, p.subkeys, p.norm_ffn_g, (bf16_t*)(ws + WS_WQK), gw, nw, lane);
            pro_transpose<false>(p.glu_w, 1024, nullptr, (bf16_t*)(ws + WS_WTGLU), gtid, nthr);
            }
            if (pm0 == 2)
            for (int l = 0; l < 2; ++l) {
                pro_table6(p.pu + (size_t)l * 16384 * 1024, p.norm_ffn_g + l * DM, ws + WS_UTAB + MB(12) * l, (float*)(ws + WS_SU) + l * 16384, gw, nw, lane);
                pro_table6(p.pv + (size_t)l * 16384 * 1024, nullptr, ws + WS_VTAB + MB(12) * l, (float*)(ws + WS_SV) + l * 16384, gw, nw, lane);
            }
            if (pm0 == 0 || pm0 == 3)
            pro_s5(p.lam_re, p.lam_im, p.b_re, p.b_im, p.c_re, p.c_im, p.log_step, (bf16_t*)(ws + WS_KTAB), (bf16_t*)(ws + WS_ME), (bf16_t*)(ws + WS_MY), (float*)(ws + WS_LAM64), smem, tid);
            if (pm0 != 0) {
            } else {
            float* ssa = (float*)(ws + WS_SSA);
            for (int i = gtid; i < 2 * T_TOK; i += nthr) ssa[i] = 0.f;
            }
        } else if (ph == 1) {
            EpiIn e{(bf16_t*)(ws + WS_Q), (bf16_t*)(ws + WS_K), (bf16_t*)(ws + WS_VT), (bf16_t*)(ws + WS_UG), (bf16_t*)(ws + WS_GG)};
            pg8::Gemm g{XB, (const bf16_t*)(ws + WS_WTIN), T_TOK, 2560, 1024}; pg8::StaticOrder S; S.init(T_TOK, 2560, gridDim.x, blockIdx.x);
            pg8::gemm_phase<EpiIn, pg8::StaticOrder, true, true>((PG8_LAS unsigned char*)smem, g, S, e);
        } else if (ph == 2) { PH_IDS
            for (int r2 = 0; r2 < ((p.rep_ph == 20 && p.rep_n > 1) ? p.rep_n : 1); ++r2)
                phase_attn((const bf16_t*)(ws + WS_Q), (const bf16_t*)(ws + WS_K), (const bf16_t*)(ws + WS_VT), (bf16_t*)(ws + WS_MIXB), gw, nw, lane);
            for (int r2 = 0; r2 < ((p.rep_ph == 21 && p.rep_n > 1) ? p.rep_n : 1); ++r2)
                phase_sgu((const bf16_t*)(ws + WS_UG), (const bf16_t*)(ws + WS_GG), p.sgu_norm_g, p.sgu_w, p.sgu_b, (bf16_t*)(ws + WS_MIXB), smem);
        } else if (ph == 3) {
            EpiRes e{p.x, p.out, XB, (float*)(ws + WS_SSA), dry};
            pg8::Gemm g{(const bf16_t*)(ws + WS_MIXB), (const bf16_t*)(ws + WS_WTOUT), T_TOK, 1024, 1024}; pg8::StaticOrder S; S.init(T_TOK, 1024, gridDim.x, blockIdx.x);
            pg8::gemm_phase<EpiRes, pg8::StaticOrder, true, true>((PG8_LAS unsigned char*)smem, g, S, e);
        }
        else if (ph == 4 || ph == 9) {
            const int l = ph == 4 ? 0 : 1;
            EpiScores e{(const float*)(ws + (l ? WS_SSB : WS_SSA)), (float*)(ws + WS_SCORES)};
            pg8::Gemm g{XB, (const bf16_t*)(ws + WS_WQK) + (size_t)l * 2048 * 1024, T_TOK, 2048, 1024}; pg8::StaticOrder S; S.init(T_TOK, 2048, gridDim.x, blockIdx.x);
            pg8::gemm_phase<EpiScores, pg8::StaticOrder, true, true>((PG8_LAS unsigned char*)smem, g, S, e);
            if (!(dry && PROBE_S5_MODE == 9))
                phase_topk_own((const float*)(ws + WS_SCORES), (int*)(ws + WS_IDX), (float*)(ws + WS_GATE), smem, S);
        } else if (ph == 6) {
            phase_expert6d<0>(XB, (const float*)(ws + WS_SSA), (const int*)(ws + WS_IDX), (const float*)(ws + WS_GATE), ws + WS_UTAB, ws + WS_VTAB, (const float*)(ws + WS_SU), (const float*)(ws + WS_SV),
                            p.out, p.norm_mix_g + DM, (bf16_t*)(ws + WS_BIG + MB(64)), smem, nb_, dry, dry ? PROBE_S5_MODE : 0);
        }
        else if (ph == 7) {
            phase_s5((const bf16_t*)(ws + WS_BIG + MB(64)), (const bf16_t*)(ws + WS_KTAB), (const bf16_t*)(ws + WS_ME), (const bf16_t*)(ws + WS_MY), (const float*)(ws + WS_LAM64), p.s5_d, (bf16_t*)(ws + WS_GBUF), smem, dry ? PROBE_S5_MODE : 0);
        } else if (ph == 8) {
            EpiGlu e{(const bf16_t*)(ws + WS_GBUF), p.glu_b, p.out, XB, (float*)(ws + WS_SSB), dry};
            pg8::Gemm g{(const bf16_t*)(ws + WS_GBUF), (const bf16_t*)(ws + WS_WTGLU), T_TOK, 1024, 1024}; pg8::StaticOrder S; S.init(T_TOK, 1024, gridDim.x, blockIdx.x);
            pg8::gemm_phase<EpiGlu, pg8::StaticOrder, true, true>((PG8_LAS unsigned char*)smem, g, S, e);
        } else if (ph == 11) {
            phase_expert6d<1>(XB, (const float*)(ws + WS_SSB), (const int*)(ws + WS_IDX), (const float*)(ws + WS_GATE), ws + WS_UTAB + MB(12), ws + WS_VTAB + MB(12), (const float*)(ws + WS_SU) + 16384, (const float*)(ws + WS_SV) + 16384,
                            p.out, p.final_g, XB, smem, nb_, dry, dry ? PROBE_S5_MODE : 0);
        }
        }
        if (ph < ph_hi || PROBE_REPLAY_K >= 0) { if (ph_lo < 0) grid.sync(); else xcd_barrier(xb); }
    }
#endif
}

static void fill_params(P& p, void* const* d_in, void* d_out, void* d_ws) {
    const float** f = (const float**)&p;
    for (int i = 0; i < 23; ++i) f[i] = (const float*)d_in[i];
    p.out = (float*)d_out; p.ws = (unsigned char*)d_ws;
}
#define LAST_OPT_PHASE 11
extern "C" void kernel_launch(void* const* d_in, const int* in_sizes, int n_in, void* d_out, int out_size, void* d_ws, size_t ws_size, hipStream_t stream) {
    static int grid = 0;
    if (!grid) {
        int dev = 0, cus = 0, per_cu = 0;
        (void)hipGetDevice(&dev); (void)hipDeviceGetAttribute(&cus, hipDeviceAttributeMultiprocessorCount, dev);
        (void)hipFuncSetAttribute((const void*)mega, hipFuncAttributeMaxDynamicSharedMemorySize, LDS_TOTAL);
        (void)hipOccupancyMaxActiveBlocksPerMultiprocessor(&per_cu, (const void*)mega, 512, LDS_TOTAL);
        if (per_cu < 1) { fprintf(stderr, "kernel_launch: occupancy query reports %d blocks/CU\n", per_cu); per_cu = 1; }
        grid = cus;
        if (ws_size < (size_t)WS_END) fprintf(stderr, "kernel_launch: workspace too small (%zu < %zu)\n", ws_size, (size_t)WS_END);
    }
    P p{}; fill_params(p, d_in, d_out, d_ws);
    p.ph_lo = 0; p.ph_hi = LAST_OPT_PHASE; p.rep_ph = PROBE_REP_PH; p.rep_n = PROBE_REP_N;
    (void)hipMemsetAsync((char*)d_ws + WS_BAR, 0, XCD_BAR_WORDS * sizeof(unsigned), stream);
    void* args[] = {&p};
    hipError_t e = hipLaunchCooperativeKernel((const void*)mega, dim3(grid), dim3(512), args, LDS_TOTAL, stream);
    if (e != hipSuccess) fprintf(stderr, "cooperative launch failed: %s (grid %d)\n", hipGetErrorString(e), grid);
}
```

```cpp
#include <hip/hip_runtime.h>
#include <hip/hip_cooperative_groups.h>
#include <cstdint>
#include <cstdio>
namespace cg = cooperative_groups;
#define PROBE_REP_PH -1
#define PROBE_REP_N 0
#define PROBE_S5_MODE 0
#define PROBE_REPLAY_K -1
#define XB_TMO      128
#define XB_XCNT(j)  (256  + 64 * (j))
#define XB_XSUB(j)  (1280 + 64 * (j))
#define XB_XGEN(j)  (2304 + 64 * (j))
#define XB_TOP      3328
#define XB_TOPGEN   3392
#define XCD_BAR_WORDS 3456
#define XB_SPIN_CAP (1u << 18)
#define LAS __attribute__((address_space(3)))

__device__ __forceinline__ unsigned xb_ld(unsigned* p)              { return __hip_atomic_load(p, __ATOMIC_RELAXED, __HIP_MEMORY_SCOPE_AGENT); }
__device__ __forceinline__ unsigned xb_add(unsigned* p, unsigned v) { return __hip_atomic_fetch_add(p, v, __ATOMIC_RELAXED, __HIP_MEMORY_SCOPE_AGENT); }
__device__ __forceinline__ unsigned xb_xcc_id() { return (unsigned)__builtin_amdgcn_s_getreg((3 << 11) | 20) & 0xFu; }
#define XB_SPIN(cond, bar) do { unsigned _sp = 0; while (cond) { __builtin_amdgcn_s_sleep(1); \
    if ((++_sp & 255u) == 0u) { if (xb_ld(&(bar)[XB_TMO])) break; if (_sp > XB_SPIN_CAP) { atomicAdd(&(bar)[XB_TMO], 1u); break; } } } } while (0)

struct XcdBarrier {
    unsigned* bar; unsigned x;
    volatile LAS unsigned* st;
};

__device__ __forceinline__ XcdBarrier xcd_barrier_post(unsigned* bar, volatile LAS unsigned* st) {
    XcdBarrier b; b.bar = bar; b.x = xb_xcc_id(); b.st = st;
    if (threadIdx.x == 0) (void)xb_add(&bar[XB_XCNT(b.x)], 1u);
    return b;
}
__device__ __forceinline__ void xcd_barrier_complete(unsigned* bar, unsigned x, unsigned& nloc, unsigned& nx) {
    const unsigned G = gridDim.x * gridDim.y * gridDim.z;
    unsigned sum, cnt, mine, sp = 0u;
    for (;;) {
        sum = 0u; cnt = 0u; mine = 0u;
#pragma unroll
        for (unsigned j = 0; j < 16; ++j) { const unsigned c = xb_ld(&bar[XB_XCNT(j)]); sum += c; cnt += (c > 0u) ? 1u : 0u; mine = (j == x) ? c : mine; }
        if (sum == G) break;
        __builtin_amdgcn_s_sleep(1);
        if ((++sp & 255u) == 0u) { if (xb_ld(&bar[XB_TMO])) break; if (sp > XB_SPIN_CAP) { atomicAdd(&bar[XB_TMO], 1u); break; } }
    }
    nloc = mine > 0u ? mine : 1u; nx = cnt > 0u ? cnt : 1u;
}

__device__ __forceinline__ void xcd_barrier(const XcdBarrier& b) {
    asm volatile("s_waitcnt vmcnt(0)" ::: "memory");
    __syncthreads();
    if (threadIdx.x == 0) {
        unsigned* bar = b.bar;
        __builtin_amdgcn_s_waitcnt(0);
        unsigned nloc = b.st[0], nx = b.st[1];
        if (nloc == 0u) { xcd_barrier_complete(bar, b.x, nloc, nx); b.st[0] = nloc; b.st[1] = nx; }
        const unsigned old = xb_add(&bar[XB_XSUB(b.x)], 1u);
        const unsigned gen = old / nloc;
        if (old + 1u == (gen + 1u) * nloc) {
            __builtin_amdgcn_fence(__ATOMIC_RELEASE, "agent");
            asm volatile("s_waitcnt vmcnt(0)" ::: "memory");
            const unsigned og = xb_add(&bar[XB_TOP], 1u);
            const unsigned tg = og / nx;
            if (og + 1u == (tg + 1u) * nx) xb_add(&bar[XB_TOPGEN], 1u);
            else XB_SPIN(xb_ld(&bar[XB_TOPGEN]) == tg, bar);
            __builtin_amdgcn_fence(__ATOMIC_ACQUIRE, "agent");
            xb_add(&bar[XB_XGEN(b.x)], 1u);
            asm volatile("s_waitcnt vmcnt(0)" ::: "memory");
        } else {
            XB_SPIN(xb_ld(&bar[XB_XGEN(b.x)]) == gen, bar);
            __builtin_amdgcn_fence(__ATOMIC_ACQUIRE, "agent");
            asm volatile("s_waitcnt vmcnt(0)" ::: "memory");
        }
    }
    __syncthreads();
}

namespace pg8 {
#define PG8_LAS __attribute__((address_space(3)))
typedef unsigned short bf16_t;
typedef short bf16x8 __attribute__((ext_vector_type(8)));
typedef float f32x4 __attribute__((ext_vector_type(4)));
typedef unsigned u32x4 __attribute__((ext_vector_type(4)));
constexpr int BM = 256, BK = 64, HALF = 128, HTB = HALF * BK * 2  , STAGE_BYTES = 8 * HTB, NXCD = 8, WGM = 8;

__host__ __device__ __forceinline__ int lds_byte(int r, int c) { const int st = (r >> 4) * 2 + (c >> 5), rr = r & 15, cc = c & 31, ob = rr * 64 + cc * 2; return st * 1024 + (ob ^ (((ob >> 9) & 1) << 5)); }
__host__ __device__ __forceinline__ void stage_rc(int b, int& R, int& C) { const int st = b / 1024, sb = b % 1024, swz = sb ^ (((sb >> 9) & 1) << 5); R = (st >> 1) * 16 + swz / 64; C = (st & 1) * 32 + (swz % 64) / 2; }
__host__ __device__ __forceinline__ int perm32(int rho) { const int n = rho >> 4, i = rho & 15; return 8 * (i >> 2) + 4 * n + (i & 3); }

struct Unit { int pm, pn; };
struct Gemm { const bf16_t* A; const bf16_t* Bt; int M, N, K; };

struct StaticOrder {
    int nM, nN, nwg, G, c;
    __host__ __device__ void init(int M, int N, int G_, int c_) { nM = M / BM; nN = N / BM; nwg = nM * nN; G = G_; c = c_; }
    __host__ __device__ bool next(int i, Unit& u) const {
        const long L = (long)i * G + c; if (L >= nwg) return false;
        int wgid = (int)L; { const int q = nwg / NXCD, r = nwg % NXCD, xcd = wgid % NXCD, off = wgid / NXCD; wgid = (xcd < r ? xcd * (q + 1) : r * (q + 1) + (xcd - r) * q) + off; }
        const int nig = WGM * nN, gid = wgid / nig, fm = gid * WGM, gsz = (nM - fm) < WGM ? (nM - fm) : WGM;
        u.pm = fm + ((wgid % nig) % gsz); u.pn = (wgid % nig) / gsz; return true;
    }
    __device__ __forceinline__ void a_ready(const Unit&) const {}
    __device__ __forceinline__ void done(const Unit&) const {}
};

template <class Epi, class Sched, bool ALIGN_EPI = false, bool SP2 = false>
__device__ __forceinline__ void gemm_phase(PG8_LAS unsigned char* lds, const Gemm g, const Sched& S, const Epi& E) {
    int tid_ = threadIdx.x; asm volatile("" : "+v"(tid_));
    const int tid = tid_, wid = __builtin_amdgcn_readfirstlane(tid >> 6), lane = tid & 63, wr = wid >> 2, wc = wid & 3, fr = lane & 15, fq = lane >> 4;
    const int K = g.K, nt = K / BK;
    unsigned voffA[2], voffB[2];
#pragma unroll
    for (int i = 0; i < 2; ++i) { int R, C; stage_rc(tid * 16 + i * 8192, R, C); const int Rb = Epi::PERM ? ((R & ~31) + perm32(R & 31)) : R;
        voffA[i] = (unsigned)(R * K + C) * 2u; voffB[i] = (unsigned)(Rb * K + C) * 2u; }
    const size_t kstep = (size_t)(BK * 2);
    const size_t hstep = (size_t)HALF * K * 2;
    const size_t tstep = 2 * hstep;
    const unsigned ldsw = (unsigned)wid * 1024u;
    const int aoff = lds_byte(wr * 64 + fr, fq * 8), boff = lds_byte(wc * 32 + fr, fq * 8);
#define PG8_SA(b, h) (((b) * 2 + (h)) * HTB)
#define PG8_SB(b, h) ((4 + (b) * 2 + (h)) * HTB)
#define PG8_STAGE(bufoff, gbase, voff) do { _Pragma("unroll") for (int _i = 0; _i < 2; ++_i) \
        __builtin_amdgcn_global_load_lds((const unsigned*)((const char*)(gbase) + (voff)[_i]), (PG8_LAS unsigned*)(lds + (bufoff) + ldsw + _i * 8192), 16, 0, 0); } while (0)
#define PG8_LDA(dst, b, h) do { _Pragma("unroll") for (int m = 0; m < 4; ++m) _Pragma("unroll") for (int k = 0; k < 2; ++k) dst[m][k] = *(const PG8_LAS bf16x8*)(lds + PG8_SA(b, h) + aoff + m * 2048 + k * 1024); } while (0)
#define PG8_LDB(dst, b, h) do { _Pragma("unroll") for (int n = 0; n < 2; ++n) _Pragma("unroll") for (int k = 0; k < 2; ++k) dst[n][k] = *(const PG8_LAS bf16x8*)(lds + PG8_SB(b, h) + boff + n * 2048 + k * 1024); } while (0)
#define PG8_MMA(ai, bj, At, Bt) do { __builtin_amdgcn_s_setprio(1); _Pragma("unroll") for (int m = 0; m < 4; ++m) _Pragma("unroll") for (int n = 0; n < 2; ++n) _Pragma("unroll") for (int k = 0; k < 2; ++k) \
        acc[ai][bj][m][n] = __builtin_amdgcn_mfma_f32_16x16x32_bf16(Bt[n][k], At[m][k], acc[ai][bj][m][n], 0, 0, 0); __builtin_amdgcn_s_setprio(0); } while (0)
#define PG8_WAIT_V(n) asm volatile("s_waitcnt vmcnt(" #n ")" ::: "memory")
#define PG8_WAIT_L(n) asm volatile("s_waitcnt lgkmcnt(" #n ")" ::: "memory")
#define PG8_BAR __builtin_amdgcn_s_barrier()
#define PG8_SCHED __builtin_amdgcn_sched_barrier(0)
    Unit cur, nxt; int ui = 0;
    if (!S.next(0, cur)) return;
    f32x4 acc[2][2][4][2];
#pragma unroll
    for (int a = 0; a < 2; ++a)
#pragma unroll
        for (int b = 0; b < 2; ++b)
#pragma unroll
            for (int m = 0; m < 4; ++m)
#pragma unroll
                for (int n = 0; n < 2; ++n) acc[a][b][m][n] = (f32x4){0.f, 0.f, 0.f, 0.f};
    bf16x8 At[4][2], B0[2][2], B1[2][2];
    const char* cA = (const char*)g.A + (size_t)cur.pm * tstep; const char* cB = (const char*)g.Bt + (size_t)cur.pn * tstep;
    S.a_ready(cur);
    if constexpr (SP2) {
        PG8_STAGE(PG8_SB(0, 0), cB, voffB); PG8_STAGE(PG8_SB(0, 1), cB + hstep, voffB); PG8_STAGE(PG8_SA(0, 0), cA, voffA); PG8_STAGE(PG8_SA(0, 1), cA + hstep, voffA);
        if (wr == 1) PG8_BAR;
        PG8_WAIT_V(2); PG8_BAR;
        PG8_STAGE(PG8_SB(1, 0), cB + kstep, voffB); PG8_STAGE(PG8_SA(1, 0), cA + kstep, voffA); PG8_STAGE(PG8_SB(1, 1), cB + hstep + kstep, voffB);
        PG8_WAIT_V(6); PG8_BAR;
    } else {
        PG8_STAGE(PG8_SB(0, 0), cB, voffB); PG8_STAGE(PG8_SA(0, 0), cA, voffA); PG8_STAGE(PG8_SB(0, 1), cB + hstep, voffB); PG8_STAGE(PG8_SA(0, 1), cA + hstep, voffA);
        if (wr == 1) PG8_BAR;
        PG8_WAIT_V(4); PG8_BAR;
        PG8_STAGE(PG8_SB(1, 0), cB + kstep, voffB); PG8_STAGE(PG8_SA(1, 0), cA + kstep, voffA); PG8_STAGE(PG8_SB(1, 1), cB + hstep + kstep, voffB);
        PG8_WAIT_V(6); PG8_BAR;
    }
    for (;;) {
        const bool has_next = S.next(ui + 1, nxt);
        const char* nA = has_next ? (const char*)g.A + (size_t)nxt.pm * tstep : cA; const char* nB = has_next ? (const char*)g.Bt + (size_t)nxt.pn * tstep : cB;
        for (int t = 0; t < nt; t += 2) {
            const bool last = (t == nt - 2);
            const char* a1 = cA + (size_t)(t + 1) * kstep;
            const char* a2 = last ? nA : cA + (size_t)(t + 2) * kstep; const char* b2 = last ? nB : cB + (size_t)(t + 2) * kstep;
            const char* a3 = a2 + kstep; const char* b3 = b2 + kstep;
            if (last && has_next) S.a_ready(nxt);
            if constexpr (SP2) {
            PG8_LDB(B0, 0, 0); PG8_LDB(B1, 0, 1); PG8_SCHED; PG8_LDA(At, 0, 0); PG8_STAGE(PG8_SA(1, 1), a1 + hstep, voffA);
            PG8_WAIT_V(8); PG8_WAIT_L(0); PG8_BAR; PG8_MMA(0, 0, At, B0); PG8_MMA(0, 1, At, B1); PG8_BAR; PG8_SCHED;
            PG8_LDA(At, 0, 1); PG8_STAGE(PG8_SB(0, 0), b2, voffB); PG8_STAGE(PG8_SB(0, 1), b2 + hstep, voffB); PG8_STAGE(PG8_SA(0, 0), a2, voffA);
            PG8_WAIT_V(8); PG8_WAIT_L(0); PG8_BAR; PG8_MMA(1, 0, At, B0); PG8_MMA(1, 1, At, B1); PG8_BAR; PG8_SCHED;
            PG8_LDB(B0, 1, 0); PG8_LDB(B1, 1, 1); PG8_SCHED; PG8_LDA(At, 1, 0); PG8_STAGE(PG8_SA(0, 1), a2 + hstep, voffA);
            PG8_WAIT_V(8); PG8_WAIT_L(0); PG8_BAR; PG8_MMA(0, 0, At, B0); PG8_MMA(0, 1, At, B1); PG8_BAR; PG8_SCHED;
            PG8_LDA(At, 1, 1); PG8_STAGE(PG8_SB(1, 0), b3, voffB); PG8_STAGE(PG8_SB(1, 1), b3 + hstep, voffB); PG8_STAGE(PG8_SA(1, 0), a3, voffA);
            PG8_WAIT_V(8); PG8_WAIT_L(0); PG8_BAR; PG8_MMA(1, 0, At, B0); PG8_MMA(1, 1, At, B1); PG8_BAR; PG8_SCHED;
            } else {
            PG8_LDB(B0, 0, 0); PG8_SCHED; PG8_LDA(At, 0, 0); PG8_STAGE(PG8_SA(1, 1), a1 + hstep, voffA);
            PG8_WAIT_L(8); PG8_BAR; PG8_WAIT_L(0); PG8_MMA(0, 0, At, B0); PG8_BAR; PG8_SCHED;
            PG8_LDB(B1, 0, 1); PG8_STAGE(PG8_SB(0, 0), b2, voffB);
            PG8_BAR; PG8_WAIT_L(0); PG8_MMA(0, 1, At, B1); PG8_BAR;
            PG8_LDA(At, 0, 1); PG8_STAGE(PG8_SA(0, 0), a2, voffA);
            PG8_BAR; PG8_WAIT_L(0); PG8_MMA(1, 0, At, B0); PG8_BAR; PG8_SCHED;
            PG8_STAGE(PG8_SB(0, 1), b2 + hstep, voffB);
            PG8_WAIT_V(6); PG8_BAR; PG8_MMA(1, 1, At, B1); PG8_BAR;
            PG8_LDB(B0, 1, 0); PG8_SCHED; PG8_LDA(At, 1, 0); PG8_STAGE(PG8_SA(0, 1), a2 + hstep, voffA);
            PG8_WAIT_L(8); PG8_BAR; PG8_WAIT_L(0); PG8_MMA(0, 0, At, B0); PG8_BAR; PG8_SCHED;
            PG8_LDB(B1, 1, 1); PG8_STAGE(PG8_SB(1, 0), b3, voffB);
            PG8_BAR; PG8_WAIT_L(0); PG8_MMA(0, 1, At, B1); PG8_BAR;
            PG8_LDA(At, 1, 1); PG8_STAGE(PG8_SA(1, 0), a3, voffA);
            PG8_BAR; PG8_WAIT_L(0); PG8_MMA(1, 0, At, B0); PG8_BAR; PG8_SCHED;
            PG8_STAGE(PG8_SB(1, 1), b3 + hstep, voffB);
            PG8_WAIT_V(6); PG8_BAR; PG8_MMA(1, 1, At, B1); PG8_BAR;
            }
        }
        if constexpr (ALIGN_EPI) { if (wr == 0) PG8_BAR; }
        if constexpr (!Epi::AFTER_DRAIN) { E(acc, cur, wr, wc, fr, fq); S.done(cur); }
        if (!has_next) break;
#pragma unroll
        for (int a = 0; a < 2; ++a)
#pragma unroll
            for (int b = 0; b < 2; ++b)
#pragma unroll
                for (int m = 0; m < 4; ++m)
#pragma unroll
                    for (int n = 0; n < 2; ++n) acc[a][b][m][n] = (f32x4){0.f, 0.f, 0.f, 0.f};
        cur = nxt; cA = nA; cB = nB; ++ui;
        if constexpr (ALIGN_EPI) { if (wr == 1) PG8_BAR; }
    }
    PG8_WAIT_V(0);
    if constexpr (!ALIGN_EPI) { if (wr == 0) PG8_BAR; }
    PG8_BAR;
    if constexpr (Epi::AFTER_DRAIN) { E.fused(acc, cur, wr, wc, fr, fq, lds, wid, lane); S.done(cur); }
#undef PG8_SA
#undef PG8_SB
#undef PG8_STAGE
#undef PG8_LDA
#undef PG8_LDB
#undef PG8_MMA
#undef PG8_WAIT_V
#undef PG8_WAIT_L
#undef PG8_BAR
#undef PG8_SCHED
}
}
typedef unsigned short bf16_t;
typedef short bf16x8 __attribute__((ext_vector_type(8)));
typedef float f32x4 __attribute__((ext_vector_type(4)));
typedef float f32x16 __attribute__((ext_vector_type(16)));
typedef unsigned u32x4 __attribute__((ext_vector_type(4)));
typedef unsigned u32x2 __attribute__((ext_vector_type(2)));
typedef __bf16 bf16x2v __attribute__((ext_vector_type(2)));

#define T_TOK 32768
#define SEQ 2048
#define DM 1024
#define MB(x) ((size_t)(x) << 20)

struct P {
    const float *x, *norm_mix_g, *norm_ffn_g, *final_g, *w_in, *sgu_norm_g, *sgu_w, *sgu_b, *w_out, *lam_re, *lam_im, *b_re, *b_im, *c_re, *c_im,
        *s5_d, *log_step, *glu_w, *glu_b, *wq, *subkeys, *pu, *pv;
    float* out;
    unsigned char* ws;
    int ph_lo, ph_hi, rep_ph, rep_n;
};
#define WS_XB MB(0)
#define WS_BIG MB(64)
#define WS_Q (WS_BIG)
#define WS_K (WS_BIG + MB(32))
#define WS_VT (WS_BIG + MB(64))
#define WS_UG (WS_BIG + MB(96))
#define WS_GG (WS_BIG + MB(128))
#define WS_MIXB (WS_BIG + MB(160))
#define WS_SCORES (WS_BIG)
#define WS_GBUF (WS_BIG)
#define WS_UTAB MB(320)
#define WS_VTAB MB(352)
#define WS_IDX MB(384)
#define WS_GATE MB(400)
#define WS_WTIN MB(416)
#define WS_WTOUT MB(421)
#define WS_WTGLU MB(423)
#define WS_WQK MB(425)
#define WS_KTAB MB(433)
#define WS_ME MB(436)
#define WS_MY MB(452)
#define WS_SSA MB(468)
#define WS_SSB (MB(468) + (128 << 10))
#define WS_LAM64 (MB(468) + (256 << 10))
#define WS_SU (MB(468) + (320 << 10))
#define WS_SV (MB(468) + (448 << 10))
#define WS_BAR (MB(468) + (576 << 10))
#define WS_END MB(469)

__device__ __forceinline__ unsigned cvt_pk_bf16(float lo, float hi) { unsigned r; asm volatile("v_cvt_pk_bf16_f32 %0, %1, %2" : "=v"(r) : "v"(lo), "v"(hi)); return r; }
__device__ __forceinline__ float bf_lo(unsigned u) { return __uint_as_float(u << 16); }
__device__ __forceinline__ float bf_hi(unsigned u) { return __uint_as_float(u & 0xffff0000u); }
__device__ __forceinline__ float gelu_t(float x) {
    const float u = 1.5957691216057308f * (x + 0.044715f * x * x * x);
    return x * __builtin_amdgcn_rcpf(1.0f + __expf(-u));
}
__device__ __forceinline__ float wave_sum(float v) {
#pragma unroll
    for (int o = 32; o > 0; o >>= 1) v += __shfl_xor(v, o);
    return v;
}
__device__ __forceinline__ bf16x8 pack8(float a0, float a1, float a2, float a3, float a4, float a5, float a6, float a7) {
    u32x4 r; r.x = cvt_pk_bf16(a0, a1); r.y = cvt_pk_bf16(a2, a3); r.z = cvt_pk_bf16(a4, a5); r.w = cvt_pk_bf16(a6, a7);
    return __builtin_bit_cast(bf16x8, r);
}
#define MFMA16(a, b, c) __builtin_amdgcn_mfma_f32_16x16x32_bf16((a), (b), (c), 0, 0, 0)
#define MFMA32(a, b, c) __builtin_amdgcn_mfma_f32_32x32x16_bf16((a), (b), (c), 0, 0, 0)

typedef f32x4 acc_t[2][2][4][2];

struct EpiIn {
    bf16_t *Q, *K, *VT, *UG, *GG;
    static constexpr bool PERM = false, AFTER_DRAIN = false;
    __device__ __forceinline__ void operator()(const acc_t& acc, const pg8::Unit& u, int wr, int wc, int fr_, int fq_) const {
        const int pm = u.pm, pn = u.pn; int fr = fr_, fq = fq_; asm volatile("" : "+v"(fr), "+v"(fq));
        const int region = pn >> 1, hg = (pn & 1) * 4 + wc;
        if (region <= 1) {
            bf16_t* base = region == 0 ? Q : K; const float sc = region == 0 ? 0.125f * 1.4426950408889634f : 1.0f;
            float invrev[2][4];
#pragma unroll
            for (int n = 0; n < 2; ++n)
#pragma unroll
                for (int j = 0; j < 4; ++j) invrev[n][j] = exp2f(-(float)(n * 16 + fq * 4 + j) * (13.287712379549449f / 32.0f)) * 0.15915494309189535f;
#pragma unroll
            for (int ai = 0; ai < 2; ++ai)
#pragma unroll
                for (int m = 0; m < 4; ++m) {
                    const int t = pm * 256 + ai * 128 + wr * 64 + m * 16 + fr, b = t >> 11, pos = t & 2047;
                    bf16_t* rowp = base + ((size_t)(b * 8 + hg) * SEQ + pos) * 64;
#pragma unroll
                    for (int n = 0; n < 2; ++n) {
                        float o1[4], o2[4];
#pragma unroll
                        for (int j = 0; j < 4; ++j) {
                            const float rev = __builtin_amdgcn_fractf((float)pos * invrev[n][j]);
                            const float sn = __builtin_amdgcn_sinf(rev), cs = __builtin_amdgcn_cosf(rev);
                            const float x1 = acc[ai][0][m][n][j], x2 = acc[ai][1][m][n][j];
                            o1[j] = (x1 * cs - x2 * sn) * sc; o2[j] = (x2 * cs + x1 * sn) * sc;
                        }
                        u32x2 w1, w2; w1.x = cvt_pk_bf16(o1[0], o1[1]); w1.y = cvt_pk_bf16(o1[2], o1[3]); w2.x = cvt_pk_bf16(o2[0], o2[1]); w2.y = cvt_pk_bf16(o2[2], o2[3]);
                        *(u32x2*)(rowp + n * 16 + fq * 4) = w1; *(u32x2*)(rowp + 32 + n * 16 + fq * 4) = w2;
                    }
                    __builtin_amdgcn_sched_barrier(0);
                }
        } else if (region == 2) {
#pragma unroll
            for (int ai = 0; ai < 2; ++ai) {
                const int t0 = pm * 256 + ai * 128 + wr * 64, b = t0 >> 11, i0 = (t0 & 2047) >> 4;
                bf16_t* vb = VT + (size_t)(b * 8 + hg) * 64 * SEQ + fr * 128 + i0;
#pragma unroll
                for (int bj = 0; bj < 2; ++bj)
#pragma unroll
                    for (int n = 0; n < 2; ++n)
#pragma unroll
                        for (int j = 0; j < 4; ++j) {
                            const int d = bj * 32 + n * 16 + fq * 4 + j;
                            u32x2 w; w.x = cvt_pk_bf16(acc[ai][bj][0][n][j], acc[ai][bj][1][n][j]); w.y = cvt_pk_bf16(acc[ai][bj][2][n][j], acc[ai][bj][3][n][j]);
                            *(u32x2*)(vb + (size_t)d * SEQ) = w;
                        }
                __builtin_amdgcn_sched_barrier(0);
            }
        } else {
            bf16_t* base = region == 3 ? UG : GG;
#pragma unroll
            for (int ai = 0; ai < 2; ++ai)
#pragma unroll
                for (int m = 0; m < 4; ++m) {
                    const int t = pm * 256 + ai * 128 + wr * 64 + m * 16 + fr;
                    bf16_t* rowp = base + (size_t)t * 512 + hg * 64;
#pragma unroll
                    for (int bj = 0; bj < 2; ++bj)
#pragma unroll
                        for (int n = 0; n < 2; ++n) {
                            const f32x4 v = acc[ai][bj][m][n];
                            u32x2 w; w.x = cvt_pk_bf16(gelu_t(v[0]), gelu_t(v[1])); w.y = cvt_pk_bf16(gelu_t(v[2]), gelu_t(v[3]));
                            *(u32x2*)(rowp + bj * 32 + n * 16 + fq * 4) = w;
                        }
                    __builtin_amdgcn_sched_barrier(0);
                }
        }
    }
};

struct EpiRes {
    const float* xin; float* xout; bf16_t* XB; float* sumsq; bool dry;
    static constexpr bool PERM = false, AFTER_DRAIN = false;
    __device__ __forceinline__ void operator()(const acc_t& acc, const pg8::Unit& u, int wr, int wc, int fr_, int fq_) const {
        const int pm = u.pm, pn = u.pn; int fr = fr_, fq = fq_; asm volatile("" : "+v"(fr), "+v"(fq));
#pragma unroll
        for (int ai = 0; ai < 2; ++ai) {
            f32x4 xv[4][2][2];
#pragma unroll
            for (int m = 0; m < 4; ++m)
#pragma unroll
                for (int bj = 0; bj < 2; ++bj)
#pragma unroll
                    for (int n = 0; n < 2; ++n) xv[m][bj][n] = *(const f32x4*)(xin + (size_t)(pm * 256 + ai * 128 + wr * 64 + m * 16 + fr) * DM + pn * 256 + bj * 128 + wc * 32 + n * 16 + fq * 4);
#pragma unroll
            for (int m = 0; m < 4; ++m) {
                const int t = pm * 256 + ai * 128 + wr * 64 + m * 16 + fr; float ss = 0.f;
#pragma unroll
                for (int bj = 0; bj < 2; ++bj)
#pragma unroll
                    for (int n = 0; n < 2; ++n) {
                        const size_t off = (size_t)t * DM + pn * 256 + bj * 128 + wc * 32 + n * 16 + fq * 4;
                        const f32x4 v = xv[m][bj][n] + acc[ai][bj][m][n];
                        u32x2 w; w.x = cvt_pk_bf16(v[0], v[1]); w.y = cvt_pk_bf16(v[2], v[3]);
                        if (!dry) *(u32x2*)(XB + off) = w;
                        ss += (v[0] * v[0] + v[1] * v[1]) + (v[2] * v[2] + v[3] * v[3]);
                    }
                ss += __shfl_xor(ss, 16); ss += __shfl_xor(ss, 32);
                if (fq == 0 && !dry) atomicAdd(sumsq + t, ss);
            }
            __builtin_amdgcn_sched_barrier(0);
        }
    }
};
__device__ __forceinline__ void pro_rmsnorm_rows(const float* __restrict__ x, const float* __restrict__ g, bf16_t* __restrict__ XB, int gw, int nw, int lane) {
    for (int t0 = gw * 2; t0 < T_TOK; t0 += nw * 2) {
        f32x4 v[2][4]; float ss[2];
#pragma unroll
        for (int u = 0; u < 2; ++u) { const float* xr = x + (size_t)(t0 + u) * DM + lane * 16;
#pragma unroll
            for (int i = 0; i < 4; ++i) v[u][i] = *(const f32x4*)(xr + 4 * i); }
#pragma unroll
        for (int u = 0; u < 2; ++u) { ss[u] = 0.f;
#pragma unroll
            for (int i = 0; i < 4; ++i) ss[u] += (v[u][i][0] * v[u][i][0] + v[u][i][1] * v[u][i][1]) + (v[u][i][2] * v[u][i][2] + v[u][i][3] * v[u][i][3]); }
#pragma unroll
        for (int o = 32; o > 0; o >>= 1) { ss[0] += __shfl_xor(ss[0], o); ss[1] += __shfl_xor(ss[1], o); }
#pragma unroll
        for (int u = 0; u < 2; ++u) {
            const float rs = rsqrtf(ss[u] * (1.0f / DM) + 1e-6f);
            u32x4 o[2];
#pragma unroll
            for (int i = 0; i < 4; ++i) { const f32x4 gv = *(const f32x4*)(g + lane * 16 + 4 * i); const f32x4 r = v[u][i] * gv * rs;
                const unsigned a = cvt_pk_bf16(r[0], r[1]), b = cvt_pk_bf16(r[2], r[3]);
                if ((i & 1) == 0) { o[i >> 1].x = a; o[i >> 1].y = b; } else { o[i >> 1].z = a; o[i >> 1].w = b; } }
            *(u32x4*)(XB + (size_t)(t0 + u) * DM + lane * 16) = o[0]; *(u32x4*)(XB + (size_t)(t0 + u) * DM + lane * 16 + 8) = o[1];
        }
    }
}
template <bool PERM>
__device__ __forceinline__ void pro_transpose(const float* __restrict__ W, int N, const float* __restrict__ g, bf16_t* __restrict__ Wt, int gtid, int nthr) {
    const int items = N * 128;
    for (int it = gtid; it < items; it += nthr) {
        const int n = it % N, k0 = (it / N) * 8; float v[8];
#pragma unroll
        for (int i = 0; i < 8; ++i) v[i] = W[(size_t)(k0 + i) * N + n] * (g ? g[k0 + i] : 1.0f);
        int np = n;
        if (PERM) { const int tl = n >> 8, l = n & 255, wc = l >> 6, bj = (l >> 5) & 1, r32 = l & 31; np = tl * 256 + bj * 128 + wc * 32 + r32; }
        *(bf16x8*)(Wt + (size_t)np * 1024 + k0) = pack8(v[0], v[1], v[2], v[3], v[4], v[5], v[6], v[7]);
    }
}

__device__ __forceinline__ void attn_range4(int cls, int r4, int tb0, int& i0, int& i_hi) {
    const bool special = ((cls ^ r4) & 3) == 0;
    int lo_s = special ? 0 : tb0 - 128; if (lo_s < 0) lo_s = 0;
    int i_lo = (lo_s - cls + 15) >> 4; if (i_lo < 0) i_lo = 0;
    i_hi = (tb0 + 12 + 240 - cls) >> 4; i0 = i_lo & ~7;
}
__device__ __forceinline__ void phase_attn(const bf16_t* __restrict__ Q, const bf16_t* __restrict__ Kp, const bf16_t* __restrict__ VT, bf16_t* __restrict__ MIXB, int gw, int nw, int lane) {
    const int x = lane & 15, g = lane >> 4;
    for (int job_ = gw; job_ < 4096; job_ += nw) {
        const int job = __builtin_amdgcn_readfirstlane(job_);
        const int bh = job >> 5, rem = job & 31, r4 = rem & 3;
        const int jblk = (job >= 2048) ? 7 - (rem >> 2) : (rem >> 2);
        const int tb0 = jblk * 256 + r4;
        bf16x8 q0[4], q1[4]; f32x4 o[4][4]; float m[4], l[4];
#pragma unroll
        for (int u = 0; u < 4; ++u) {
            const bf16_t* Qp = Q + ((size_t)bh * SEQ + tb0 + 4 * u + 16 * x) * 64 + 8 * g;
            q0[u] = *(const bf16x8*)Qp; q1[u] = *(const bf16x8*)(Qp + 32); m[u] = -1e30f; l[u] = 0.f;
#pragma unroll
            for (int n = 0; n < 4; ++n) o[u][n] = (f32x4){0.f, 0.f, 0.f, 0.f};
        }
        const bf16_t* Kb = Kp + (size_t)bh * SEQ * 64 + 8 * g;
        const bf16_t* Vb = VT + (size_t)bh * 64 * SEQ + (size_t)x * SEQ;
        const int xo = 8 * (x >> 2) + (x & 3);
        int cls = 0, ib, i_hi; attn_range4(0, r4, tb0, ib, i_hi);
        bf16x8 kc[4], vc[4];
#define ATTN_LOADK(KD, CLS, IB) do { const int _iA = (IB) + xo, _iB = _iA + 4; const int _iAc = _iA < 127 ? _iA : 127, _iBc = _iB < 127 ? _iB : 127; \
            const bf16_t* _ka = Kb + (size_t)((CLS) + 16 * _iAc) * 64; const bf16_t* _kb = Kb + (size_t)((CLS) + 16 * _iBc) * 64; \
            KD[0] = *(const bf16x8*)_ka; KD[1] = *(const bf16x8*)(_ka + 32); KD[2] = *(const bf16x8*)_kb; KD[3] = *(const bf16x8*)(_kb + 32); } while (0)
#define ATTN_LOADV(VD, CLS, IB) do { int _iv = (IB) + 8 * g; if (_iv > 120) _iv = 120; \
            _Pragma("unroll") for (int n = 0; n < 4; ++n) VD[n] = *(const bf16x8*)(Vb + (size_t)(16 * n) * SEQ + (CLS) * 128 + _iv); } while (0)
        ATTN_LOADK(kc, cls, ib);
        bool more = true;
        bf16x8 kd[4];
#define ATTN_BODY(KC, KN) do { \
            ATTN_LOADV(vc, cls, ib); \
            int ncls = cls, nib = ib + 32, nhi = i_hi; \
            if (nib > i_hi) { ncls = cls + 1; if (ncls < 16) attn_range4(ncls, r4, tb0, nib, nhi); } \
            more = ncls < 16; \
            { const int lc = more ? ncls : cls, li = more ? nib : ib; ATTN_LOADK(KN, lc, li); } \
            const bool special = ((cls ^ r4) & 3) == 0; const int ustar = (cls - r4) >> 2; \
            const int dbase = tb0 + 16 * x - cls - 16 * (ib + 8 * g); \
            _Pragma("unroll") \
            for (int u = 0; u < 4; ++u) { \
                const int c3 = (special && u == ustar) ? 1 : 0; \
                f32x4 sA = (f32x4){0.f, 0.f, 0.f, 0.f}, sB = (f32x4){0.f, 0.f, 0.f, 0.f}; \
                sA = MFMA16(KC[0], q0[u], sA); sA = MFMA16(KC[1], q1[u], sA); \
                sB = MFMA16(KC[2], q0[u], sB); sB = MFMA16(KC[3], q1[u], sB); \
                float sc[8]; float mt = -INFINITY; \
                if (special) { \
            _Pragma("unroll") \
                    for (int jj = 0; jj < 8; ++jj) { \
                        const int delta = dbase + 4 * u - 16 * jj; \
                        const int mult = (delta >= 0) ? (c3 + (delta <= 512 ? 1 : 0) + (delta <= 128 ? 1 : 0)) : 0; \
                        const float bias = mult == 3 ? 1.584962500721156f : (mult == 2 ? 1.0f : 0.0f); \
                        const float s = (jj < 4 ? sA[jj & 3] : sB[jj & 3]) + bias; \
                        sc[jj] = mult > 0 ? s : -INFINITY; mt = fmaxf(mt, sc[jj]); \
                    } \
                } else { \
            _Pragma("unroll") \
                    for (int jj = 0; jj < 8; ++jj) { \
                        const unsigned delta = (unsigned)(dbase + 4 * u - 16 * jj); \
                        sc[jj] = delta <= 128u ? (jj < 4 ? sA[jj & 3] : sB[jj & 3]) : -INFINITY; mt = fmaxf(mt, sc[jj]); \
                    } \
                } \
                { const auto s16 = __builtin_amdgcn_permlane16_swap(__float_as_uint(mt), __float_as_uint(mt), false, false); mt = fmaxf(__uint_as_float(s16[0]), __uint_as_float(s16[1])); \
                  const auto s32 = __builtin_amdgcn_permlane32_swap(__float_as_uint(mt), __float_as_uint(mt), false, false); mt = fmaxf(__uint_as_float(s32[0]), __uint_as_float(s32[1])); } \
                if (__builtin_amdgcn_ballot_w64(mt > m[u]) != 0ull) { \
                    const float mn = fmaxf(m[u], mt), alpha = __builtin_amdgcn_exp2f(m[u] - mn); m[u] = mn; l[u] *= alpha; \
            _Pragma("unroll") \
                    for (int n = 0; n < 4; ++n) o[u][n] = o[u][n] * alpha; \
                } \
                const float mn = m[u]; \
                float pj[8], ps = 0.f; \
            _Pragma("unroll") \
                for (int jj = 0; jj < 8; ++jj) { pj[jj] = __builtin_amdgcn_exp2f(sc[jj] - mn); ps += pj[jj]; } \
                l[u] += ps; \
                const bf16x8 pf = pack8(pj[0], pj[1], pj[2], pj[3], pj[4], pj[5], pj[6], pj[7]); \
            _Pragma("unroll") \
                for (int n = 0; n < 4; ++n) o[u][n] = MFMA16(vc[n], pf, o[u][n]); \
            } \
            cls = ncls; ib = nib; i_hi = nhi; } while (0)
#pragma unroll 1
        while (more) {
            ATTN_BODY(kc, kd);
            if (!more) break;
            ATTN_BODY(kd, kc);
        }
#undef ATTN_BODY
#undef ATTN_LOADK
#undef ATTN_LOADV
        const int b = bh >> 3, h = bh & 7;
#pragma unroll
        for (int u = 0; u < 4; ++u) {
            float lt = l[u]; lt += __shfl_xor(lt, 16); lt += __shfl_xor(lt, 32);
            const float inv = 1.0f / lt;
            bf16_t* op = MIXB + (size_t)(b * SEQ + tb0 + 4 * u + 16 * x) * DM + h * 64 + 4 * g;
#pragma unroll
            for (int n = 0; n < 4; ++n) { u32x2 w; w.x = cvt_pk_bf16(o[u][n][0] * inv, o[u][n][1] * inv); w.y = cvt_pk_bf16(o[u][n][2] * inv, o[u][n][3] * inv); *(u32x2*)(op + 16 * n) = w; }
        }
    }
}

__device__ __forceinline__ void phase_sgu(const bf16_t* __restrict__ UG, const bf16_t* __restrict__ GG, const float* __restrict__ sgn, const float* __restrict__ sgw,
                                          const float* __restrict__ sgb, bf16_t* __restrict__ MIXB, unsigned char* smem) {
    bf16_t* GT = (bf16_t*)smem;
    int tid_ = threadIdx.x; asm volatile("" : "+v"(tid_));
    const int tid = tid_, lane = tid & 63, w = tid >> 6, x = lane & 15, g = lane >> 4;
    for (int item = blockIdx.x; item < 2048; item += gridDim.x) {
        const int h = item & 7, t0 = (item >> 3) * 128;
        __syncthreads();
#pragma unroll
        for (int pass = 0; pass < 2; ++pass) {
            const int j = pass * 64 + (tid >> 3), part = tid & 7;
            const u32x4 raw = *(const u32x4*)(GG + (size_t)(t0 + j) * 512 + h * 64 + part * 8);
            float v[8] = {bf_lo(raw.x), bf_hi(raw.x), bf_lo(raw.y), bf_hi(raw.y), bf_lo(raw.z), bf_hi(raw.z), bf_lo(raw.w), bf_hi(raw.w)};
            float s = 0.f;
#pragma unroll
            for (int e = 0; e < 8; ++e) s += v[e];
            s += __shfl_xor(s, 1); s += __shfl_xor(s, 2); s += __shfl_xor(s, 4);
            const float mu = s * (1.0f / 64.0f); float q = 0.f;
#pragma unroll
            for (int e = 0; e < 8; ++e) { v[e] -= mu; q += v[e] * v[e]; }
            q += __shfl_xor(q, 1); q += __shfl_xor(q, 2); q += __shfl_xor(q, 4);
            const float rs = rsqrtf(q * (1.0f / 64.0f) + 1e-5f);
#pragma unroll
            for (int e = 0; e < 8; ++e) GT[(part * 8 + e) * 136 + j] = (bf16_t)(cvt_pk_bf16(v[e] * rs * sgn[h * 64 + part * 8 + e], 0.f) & 0xffffu);
        }
        __syncthreads();
        const int i = 16 * w + x;
        f32x4 acc[4];
#pragma unroll
        for (int n = 0; n < 4; ++n) acc[n] = (f32x4){0.f, 0.f, 0.f, 0.f};
        const int ksmax = (16 * w + 15) >> 5;
        for (int ks = 0; ks <= ksmax; ++ks) {
            const float* wp = sgw + (size_t)(h * 128 + i) * 128 + 32 * ks + 8 * g;
            const f32x4 w0 = *(const f32x4*)wp, w1 = *(const f32x4*)(wp + 4);
            const int jb = 32 * ks + 8 * g;
            const bf16x8 wf = pack8(jb + 0 <= i ? w0[0] : 0.f, jb + 1 <= i ? w0[1] : 0.f, jb + 2 <= i ? w0[2] : 0.f, jb + 3 <= i ? w0[3] : 0.f,
                                    jb + 4 <= i ? w1[0] : 0.f, jb + 5 <= i ? w1[1] : 0.f, jb + 6 <= i ? w1[2] : 0.f, jb + 7 <= i ? w1[3] : 0.f);
#pragma unroll
            for (int n = 0; n < 4; ++n) { const bf16x8 af = *(const bf16x8*)(GT + (16 * n + x) * 136 + 32 * ks + 8 * g); acc[n] = MFMA16(af, wf, acc[n]); }
        }
        const float bi = sgb[h * 128 + i]; const size_t t = (size_t)t0 + i;
#pragma unroll
        for (int n = 0; n < 4; ++n) {
            const u32x2 ur = *(const u32x2*)(UG + t * 512 + h * 64 + 16 * n + 4 * g);
            u32x2 o; o.x = cvt_pk_bf16(bf_lo(ur.x) * (acc[n][0] + bi), bf_hi(ur.x) * (acc[n][1] + bi)); o.y = cvt_pk_bf16(bf_lo(ur.y) * (acc[n][2] + bi), bf_hi(ur.y) * (acc[n][3] + bi));
            *(u32x2*)(MIXB + t * DM + 512 + h * 64 + 16 * n + 4 * g) = o;
        }
    }
}
__device__ __forceinline__ void pro_wqk(const float* __restrict__ wq, const float* __restrict__ sk, const float* __restrict__ gffn, bf16_t* __restrict__ Wqk, int gw, int nw, int lane) {
    const int r = lane & 31, half = lane >> 5;
    for (int tile = gw; tile < 4096; tile += nw) {
        const int kblk = tile & 31, kb = (tile >> 5) & 3, hp = (tile >> 7) & 15, l = tile >> 11, p = hp & 1;
        const float* ap = sk + ((size_t)((l * 2 + p) * 128 + kb * 32 + r)) * 128 + 64 * half;
        const float* bp = wq + ((size_t)l * 1024 + kblk * 32 + r) * 2048 + hp * 128 + 64 * half;
        f32x16 acc;
#pragma unroll
        for (int i = 0; i < 16; ++i) acc[i] = 0.f;
#pragma unroll
        for (int ch = 0; ch < 4; ++ch) {
            f32x4 a[4], b[4];
#pragma unroll
            for (int i = 0; i < 4; ++i) { a[i] = *(const f32x4*)(ap + ch * 16 + 4 * i); b[i] = *(const f32x4*)(bp + ch * 16 + 4 * i); }
#pragma unroll
            for (int i = 0; i < 4; ++i)
#pragma unroll
                for (int j = 0; j < 4; ++j) acc = __builtin_amdgcn_mfma_f32_32x32x2f32(a[i][j], b[i][j], acc, 0, 0, 0);
        }
        const float gk = gffn[l * 1024 + kblk * 32 + r];
        bf16_t* op = Wqk + ((size_t)l * 2048 + hp * 128 + kb * 32) * 1024 + kblk * 32 + r;
#pragma unroll
        for (int i = 0; i < 16; ++i) { const int row = (i & 3) + 8 * (i >> 2) + 4 * half; op[(size_t)row * 1024] = (bf16_t)(cvt_pk_bf16(acc[i] * gk, 0.f) & 0xffffu); }
    }
}
__device__ __forceinline__ void pro_tables(const float* __restrict__ pu, const float* __restrict__ pv, const float* __restrict__ g, bf16_t* __restrict__ Ut, bf16_t* __restrict__ Vt, int gtid, int nthr) {
    const int items = 16384 * 128;
    for (int it = gtid; it < items; it += nthr) {
        const size_t off = (size_t)it * 8; const int d = (it & 127) * 8;
        const f32x4 a0 = *(const f32x4*)(pu + off), a1 = *(const f32x4*)(pu + off + 4), g0 = *(const f32x4*)(g + d), g1 = *(const f32x4*)(g + d + 4);
        *(bf16x8*)(Ut + off) = pack8(a0[0] * g0[0], a0[1] * g0[1], a0[2] * g0[2], a0[3] * g0[3], a1[0] * g1[0], a1[1] * g1[1], a1[2] * g1[2], a1[3] * g1[3]);
        const f32x4 b0 = *(const f32x4*)(pv + off), b1 = *(const f32x4*)(pv + off + 4);
        *(bf16x8*)(Vt + off) = pack8(b0[0], b0[1], b0[2], b0[3], b1[0], b1[1], b1[2], b1[3]);
    }
}

struct EpiScores {
    const float* sumsq; float* ST;
    static constexpr bool PERM = false, AFTER_DRAIN = false;
    __device__ __forceinline__ void operator()(const acc_t& acc, const pg8::Unit& u, int wr, int wc, int fr_, int fq_) const {
        const int pm = u.pm, pn = u.pn; int fr = fr_, fq = fq_; asm volatile("" : "+v"(fr), "+v"(fq));
        float ssq[2][4];
#pragma unroll
        for (int ai = 0; ai < 2; ++ai)
#pragma unroll
            for (int m = 0; m < 4; ++m) ssq[ai][m] = sumsq[pm * 256 + ai * 128 + wr * 64 + m * 16 + fr];
#pragma unroll
        for (int ai = 0; ai < 2; ++ai)
#pragma unroll
            for (int m = 0; m < 4; ++m) {
                const int t = pm * 256 + ai * 128 + wr * 64 + m * 16 + fr;
                const float rs = rsqrtf(ssq[ai][m] * (1.0f / DM) + 1e-6f);
                float* base = ST + (((size_t)(t >> 6) * 512 + pn * 64 + wc * 8 + fq) * 64 + (t & 63)) * 4;
#pragma unroll
                for (int bj = 0; bj < 2; ++bj)
#pragma unroll
                    for (int n = 0; n < 2; ++n) *(f32x4*)(base + (size_t)(bj * 32 + n * 4) * 256) = acc[ai][bj][m][n] * rs;
                __builtin_amdgcn_sched_barrier(0);
            }
    }
};

__device__ __forceinline__ unsigned ord_key(float f) { const unsigned u = __float_as_uint(f); return (u & 0x80000000u) ? ~u : (u | 0x80000000u); }
__device__ __forceinline__ float ord_val(unsigned k) { const unsigned u = (k & 0x80000000u) ? (k & 0x7fffffffu) : ~k; return __uint_as_float(u); }
#define INS16(A, KEY) do { unsigned _k = (KEY); _Pragma("unroll") for (int _s = 0; _s < 16; ++_s) { const unsigned _hi = max(A[_s], _k); _k = min(A[_s], _k); A[_s] = _hi; } } while (0)


#define TK_CE(A, I, J) do { const unsigned _h = max(A[I], A[J]), _l = min(A[I], A[J]); A[I] = _h; A[J] = _l; } while (0)
__device__ __forceinline__ void tk_sort16(unsigned (&v)[16]) {
#pragma unroll
    for (int k = 2; k <= 16; k <<= 1)
#pragma unroll
        for (int j = k >> 1; j >= 1; j >>= 1)
#pragma unroll
            for (int i = 0; i < 16; ++i) { const int l = i ^ j; if (l > i) { if ((i & k) == 0 || k == 16) TK_CE(v, i, l); else TK_CE(v, l, i); } }
}
__device__ __forceinline__ void tk_merge16(unsigned (&a)[16], const unsigned (&b)[16]) {
#pragma unroll
    for (int i = 0; i < 16; ++i) a[i] = max(a[i], b[15 - i]);
#pragma unroll
    for (int j = 8; j >= 1; j >>= 1)
#pragma unroll
        for (int i = 0; i < 16; ++i) { const int l = i ^ j; if (l > i) TK_CE(a, i, l); }
}

__device__ __forceinline__ void topk_item(const float* __restrict__ ST, int* __restrict__ idx, float* __restrict__ gate, unsigned* L, int item, int tid, int lane) {
    {
        const int tt = item >> 3, h = item & 7;
        const float* sp = ST + (((size_t)tt * 512 + h * 64) * 64 + lane) * 4;
        unsigned a0[16], a1[16];
#pragma unroll
        for (int s = 0; s < 16; ++s) { a0[s] = 0u; a1[s] = 0u; }
        float bufk[3][32];
#define TK_LOAD(B, BLK) do { _Pragma("unroll") for (int i = 0; i < 8; ++i) { const f32x4 v = *(const f32x4*)(sp + (size_t)((BLK) * 8 + i) * 256); B[4 * i] = v[0]; B[4 * i + 1] = v[1]; B[4 * i + 2] = v[2]; B[4 * i + 3] = v[3]; } } while (0)
        TK_LOAD(bufk[0], 0); TK_LOAD(bufk[1], 1);
#pragma unroll
        for (int blk = 0; blk < 8; ++blk) {
            if (blk < 6) TK_LOAD(bufk[(blk + 2) % 3], blk + 2);
#pragma unroll
            for (int hb = 0; hb < 2; ++hb) {
                unsigned b16[16];
#pragma unroll
                for (int i = 0; i < 16; ++i) b16[i] = (ord_key(bufk[blk % 3][16 * hb + i]) & ~127u) | (unsigned)(127 - ((blk & 3) * 32 + 16 * hb + i));
                tk_sort16(b16);
                if (blk < 4) { if (blk == 0 && hb == 0) {
#pragma unroll
                        for (int i = 0; i < 16; ++i) a0[i] = b16[i]; } else tk_merge16(a0, b16); }
                else { if (blk == 4 && hb == 0) {
#pragma unroll
                        for (int i = 0; i < 16; ++i) a1[i] = b16[i]; } else tk_merge16(a1, b16); }
            }
        }
#undef TK_LOAD
#pragma unroll
        for (int s = 0; s < 16; ++s) { L[s * 512 + tid] = a0[s]; L[(16 + s) * 512 + tid] = a1[s]; }
        unsigned c[16];
#pragma unroll
        for (int s = 0; s < 16; ++s) c[s] = 0u;
#pragma unroll
        for (int ri = 0; ri < 16; ++ri)
#pragma unroll
            for (int rj = 0; rj < 16; ++rj)
                if ((ri + 1) * (rj + 1) <= 16) { const float sm = ord_val(a0[ri] & ~127u) + ord_val(a1[rj] & ~127u); const unsigned k = (ord_key(sm) & ~255u) | (unsigned)(255 - (ri * 16 + rj)); INS16(c, k); }
        float sv[16]; int ei[16]; float mx = -INFINITY;
#pragma unroll
        for (int s = 0; s < 16; ++s) {
            const unsigned code = 255u - (c[s] & 255u); const unsigned k0 = L[(code >> 4) * 512 + tid], k1 = L[(16 + (code & 15)) * 512 + tid];
            sv[s] = ord_val(k0 & ~127u) + ord_val(k1 & ~127u); ei[s] = (int)((127u - (k0 & 127u)) * 128u + (127u - (k1 & 127u))); mx = fmaxf(mx, sv[s]);
        }
        float sum = 0.f;
#pragma unroll
        for (int s = 0; s < 16; ++s) { sv[s] = __expf(sv[s] - mx); sum += sv[s]; }
        const float inv = 1.0f / sum; const size_t ob = ((size_t)tt * 64 + lane) * 128 + h * 16;
#pragma unroll
        for (int s = 0; s < 16; s += 4) {
            *(int4*)(idx + ob + s) = make_int4(ei[s], ei[s + 1], ei[s + 2], ei[s + 3]);
            *(f32x4*)(gate + ob + s) = (f32x4){sv[s] * inv, sv[s + 1] * inv, sv[s + 2] * inv, sv[s + 3] * inv};
        }
    }
}

__device__ __forceinline__ float dot2bf(unsigned a, unsigned b, float c) { return __builtin_amdgcn_fdot2_f32_bf16(__builtin_bit_cast(bf16x2v, a), __builtin_bit_cast(bf16x2v, b), c, false); }

template <int MODE>
__device__ __forceinline__ void phase_expert(const bf16_t* __restrict__ XB, const float* __restrict__ sumsq, const int* __restrict__ idx, const float* __restrict__ gate,
                                             const bf16_t* __restrict__ Ut, const bf16_t* __restrict__ Vt, float* __restrict__ x, const float* __restrict__ gnext,
                                             bf16_t* __restrict__ XBout, int gw, int nw, int lane, bool dry) {
    for (int t0 = gw; t0 < T_TOK; t0 += nw) {
        const int t = __builtin_amdgcn_readfirstlane(t0);
        const u32x4 xa = *(const u32x4*)(XB + (size_t)t * DM + lane * 16), xb = *(const u32x4*)(XB + (size_t)t * DM + lane * 16 + 8);
        const float rs = rsqrtf(sumsq[t] * (1.0f / DM) + 1e-6f);
        float y[16];
#pragma unroll
        for (int i = 0; i < 16; ++i) y[i] = 0.f;
        const int myp = (lane >> 3) & 7;
#pragma unroll 1
        for (int grp = 0; grp < 16; ++grp) {
            const int* ip = idx + (size_t)t * 128 + grp * 8;
            int e[8];
#pragma unroll
            for (int k = 0; k < 8; ++k) e[k] = __builtin_amdgcn_readfirstlane(ip[k]);
            u32x4 ua[8], ub[8];
#pragma unroll
            for (int k = 0; k < 8; ++k) { const bf16_t* up = Ut + (size_t)e[k] * DM + lane * 16; ua[k] = *(const u32x4*)up; ub[k] = *(const u32x4*)(up + 8); }
            float d[8];
#pragma unroll
            for (int k = 0; k < 8; ++k) {
                float s0 = dot2bf(ua[k].x, xa.x, 0.f), s1 = dot2bf(ua[k].y, xa.y, 0.f);
                s0 = dot2bf(ua[k].z, xa.z, s0); s1 = dot2bf(ua[k].w, xa.w, s1);
                s0 = dot2bf(ub[k].x, xb.x, s0); s1 = dot2bf(ub[k].y, xb.y, s1);
                s0 = dot2bf(ub[k].z, xb.z, s0); s1 = dot2bf(ub[k].w, xb.w, s1);
                d[k] = s0 + s1;
            }
            float r4[4], r2[2], r1;
            { const bool hi = (lane & 32) != 0;
#pragma unroll
              for (int i = 0; i < 4; ++i) { const float keep = hi ? d[i + 4] : d[i], send = hi ? d[i] : d[i + 4]; r4[i] = keep + __shfl_xor(send, 32); } }
            { const bool hi = (lane & 16) != 0;
#pragma unroll
              for (int i = 0; i < 2; ++i) { const float keep = hi ? r4[i + 2] : r4[i], send = hi ? r4[i] : r4[i + 2]; r2[i] = keep + __shfl_xor(send, 16); } }
            { const bool hi = (lane & 8) != 0; const float keep = hi ? r2[1] : r2[0], send = hi ? r2[0] : r2[1]; r1 = keep + __shfl_xor(send, 8); }
            r1 += __shfl_xor(r1, 4); r1 += __shfl_xor(r1, 2); r1 += __shfl_xor(r1, 1);
            const int pk = ((lane >> 5) & 1) * 4 + ((lane >> 4) & 1) * 2 + ((lane >> 3) & 1);
            const float gk = gate[(size_t)t * 128 + grp * 8 + pk];
            const float wgt = gk * gelu_t(r1 * rs);
            (void)myp;
#pragma unroll
            for (int k = 0; k < 8; ++k) {
                const float wk = __uint_as_float(__builtin_amdgcn_readlane(__float_as_uint(wgt), ((k >> 2) & 1) * 32 + ((k >> 1) & 1) * 16 + (k & 1) * 8));
                const bf16_t* vp = Vt + (size_t)e[k] * DM + lane * 16;
                const u32x4 va = *(const u32x4*)vp, vb = *(const u32x4*)(vp + 8);
                y[0] += wk * bf_lo(va.x); y[1] += wk * bf_hi(va.x); y[2] += wk * bf_lo(va.y); y[3] += wk * bf_hi(va.y);
                y[4] += wk * bf_lo(va.z); y[5] += wk * bf_hi(va.z); y[6] += wk * bf_lo(va.w); y[7] += wk * bf_hi(va.w);
                y[8] += wk * bf_lo(vb.x); y[9] += wk * bf_hi(vb.x); y[10] += wk * bf_lo(vb.y); y[11] += wk * bf_hi(vb.y);
                y[12] += wk * bf_lo(vb.z); y[13] += wk * bf_hi(vb.z); y[14] += wk * bf_lo(vb.w); y[15] += wk * bf_hi(vb.w);
            }
        }
        float* xr = x + (size_t)t * DM + lane * 16; float ss = 0.f; f32x4 xn[4];
#pragma unroll
        for (int i = 0; i < 4; ++i) { const f32x4 xv = *(const f32x4*)(xr + 4 * i); xn[i] = xv + (f32x4){y[4 * i], y[4 * i + 1], y[4 * i + 2], y[4 * i + 3]};
            ss += (xn[i][0] * xn[i][0] + xn[i][1] * xn[i][1]) + (xn[i][2] * xn[i][2] + xn[i][3] * xn[i][3]); }
        ss = wave_sum(ss); const float rn = rsqrtf(ss * (1.0f / DM) + 1e-6f);
        if (dry) continue;
        if (MODE == 0) {
            u32x4 o[2];
#pragma unroll
            for (int i = 0; i < 4; ++i) { *(f32x4*)(xr + 4 * i) = xn[i]; const f32x4 gv = *(const f32x4*)(gnext + lane * 16 + 4 * i); const f32x4 r = xn[i] * gv * rn;
                const unsigned a = cvt_pk_bf16(r[0], r[1]), b = cvt_pk_bf16(r[2], r[3]);
                if ((i & 1) == 0) { o[i >> 1].x = a; o[i >> 1].y = b; } else { o[i >> 1].z = a; o[i >> 1].w = b; } }
            *(u32x4*)(XBout + (size_t)t * DM + lane * 16) = o[0]; *(u32x4*)(XBout + (size_t)t * DM + lane * 16 + 8) = o[1];
        } else {
#pragma unroll
            for (int i = 0; i < 4; ++i) { const f32x4 gv = *(const f32x4*)(gnext + lane * 16 + 4 * i); *(f32x4*)(xr + 4 * i) = xn[i] * gv * rn; }
        }
    }
}

__device__ __forceinline__ void phase_topk_own(const float* __restrict__ ST, int* __restrict__ idx, float* __restrict__ gate, unsigned char* smem, const pg8::StaticOrder& S) {
    asm volatile("s_waitcnt vmcnt(0)" ::: "memory");
    __syncthreads();
    __builtin_amdgcn_fence(__ATOMIC_ACQUIRE, "agent");
    asm volatile("s_waitcnt vmcnt(0)" ::: "memory");
    int tid_ = threadIdx.x; asm volatile("" : "+v"(tid_));
    const int tid = tid_, lane = tid & 63, w = __builtin_amdgcn_readfirstlane(tid >> 6);
#pragma unroll 1
    for (int li = w;; li += 8) { pg8::Unit u; if (!S.next(li >> 2, u)) break;
        topk_item(ST, idx, gate, (unsigned*)smem, (u.pm * 4 + (li & 3)) * 8 + u.pn, tid, lane); }
    __syncthreads();
}
__device__ __forceinline__ void pro_s5(const float* __restrict__ lre, const float* __restrict__ lim, const float* __restrict__ bre, const float* __restrict__ bim,
                                       const float* __restrict__ cre, const float* __restrict__ cim, const float* __restrict__ lstep,
                                       bf16_t* __restrict__ Ktab, bf16_t* __restrict__ ME, bf16_t* __restrict__ MY, float* __restrict__ lam64, unsigned char* smem, int tid) {
    float2* LP = (float2*)smem;
    float2* BB = (float2*)(smem + 33280);
    float2* CC = (float2*)(smem + 33280 + 8192);
    for (int gi = blockIdx.x; gi < 256; gi += gridDim.x) {
        const int g = gi >> 2, part = gi & 3;
        __syncthreads();
        const float dt = expf(lstep[g]);
        for (int e = tid; e < 65 * 64; e += 512) {
            const int n = e >> 6, p = e & 63; const float lr = lre[g * 64 + p], li = lim[g * 64 + p];
            double rev = (double)li * (double)dt * (double)n * 0.15915494309189535; rev -= floor(rev);
            const float ang = (float)(rev * 6.283185307179586); const float mg = expf(lr * dt * (float)n);
            LP[e] = make_float2(mg * cosf(ang), mg * sinf(ang));
        }
        for (int e = tid; e < 1024; e += 512) {
            const int p = e >> 4, c = e & 15; const float lr = lre[g * 64 + p], li = lim[g * 64 + p];
            const float decay = expf(lr * dt), ar = decay * cosf(li * dt), ai = decay * sinf(li * dt), mag = lr * lr + li * li;
            const float kr = ((ar - 1.0f) * lr + ai * li) / mag, ki = (ai * lr - (ar - 1.0f) * li) / mag;
            const float br = bre[(g * 64 + p) * 16 + c], bi = bim[(g * 64 + p) * 16 + c];
            BB[e] = make_float2(kr * br - ki * bi, kr * bi + ki * br);
            const int c2 = e >> 6, p2 = e & 63;
            CC[e] = make_float2(cre[(g * 16 + c2) * 64 + p2], cim[(g * 16 + c2) * 64 + p2]);
        }
        __syncthreads();
        for (int e = tid + 512 * part; e < 65 * 256; e += 2048) {
            const int row = e >> 8, c = (e >> 4) & 15, c1 = e & 15; float s = 0.f;
            if (row > 0) { const int tau = row - 1;
                for (int p = 0; p < 64; ++p) { const float2 C = CC[c * 64 + p], L = LP[tau * 64 + p], B = BB[p * 16 + c1];
                    const float wr_ = C.x * L.x - C.y * L.y, wi_ = C.x * L.y + C.y * L.x; s += wr_ * B.x - wi_ * B.y; } }
            Ktab[(size_t)g * (65 * 256) + e] = (bf16_t)(cvt_pk_bf16(s, 0.f) & 0xffffu);
        }
        for (int e = tid + 512 * part; e < 128 * 1024; e += 2048) {
            const int row = e >> 10, k = e & 1023, ri = row >> 6, p = row & 63, j = k >> 4, c1 = k & 15;
            const float2 L = LP[(63 - j) * 64 + p], B = BB[p * 16 + c1];
            const float v = ri == 0 ? (L.x * B.x - L.y * B.y) : (L.x * B.y + L.y * B.x);
            ME[(size_t)g * (128 * 1024) + ((((row >> 5) * 64 + j) * 64 + (row & 31) + 32 * ((k >> 3) & 1)) << 3) + (k & 7)] = (bf16_t)(cvt_pk_bf16(v, 0.f) & 0xffffu);
        }
        for (int e = tid + 512 * part; e < 1024 * 128; e += 2048) {
            const int row = e >> 7, k = e & 127, t = row >> 4, c = row & 15, ri = k >> 6, p = k & 63;
            const float2 C = CC[c * 64 + p], L = LP[(t + 1) * 64 + p];
            const float v = ri == 0 ? (C.x * L.x - C.y * L.y) : -(C.x * L.y + C.y * L.x);
            MY[(size_t)g * (1024 * 128) + ((((row >> 5) * 8 + (k >> 4)) * 64 + (row & 31) + 32 * ((k >> 3) & 1)) << 3) + (k & 7)] = (bf16_t)(cvt_pk_bf16(v, 0.f) & 0xffffu);
        }
        if (tid < 64 && part == 0) { const float2 L = LP[64 * 64 + tid]; lam64[(g * 64 + tid) * 2] = L.x; lam64[(g * 64 + tid) * 2 + 1] = L.y; }
    }
}

__device__ __forceinline__ void phase_s5(const bf16_t* __restrict__ HN, const bf16_t* __restrict__ Ktab, const bf16_t* __restrict__ ME, const bf16_t* __restrict__ MY,
                                         const float* __restrict__ lam64, const float* __restrict__ s5d, bf16_t* __restrict__ GBUF, unsigned char* smem, int mode) {
    bf16_t* Ks = (bf16_t*)smem;
    unsigned char* Us = smem + 33280;
    float* Es = (float*)(smem + 33280 + 66560);
    bf16_t* Ss = (bf16_t*)(smem + 33280 + 66560 + 32768);
    const int w = __builtin_amdgcn_readfirstlane(threadIdx.x >> 6);
    int curg = -1;
    for (int it = blockIdx.x * 4; it < 1024; it += gridDim.x * 4)
        for (int k4 = 0; k4 < 4; ++k4) {
            int tid_ = threadIdx.x; asm volatile("" : "+v"(tid_));
            const int tid = tid_, lane = tid & 63, r = lane & 31, half = lane >> 5;
            const int item = it + k4, g = item >> 4, b = item & 15;
            __syncthreads();
            if (g != curg) { for (int e = tid; e < 2080; e += 512) *(u32x4*)(Ks + e * 8) = *(const u32x4*)(Ktab + (size_t)g * (65 * 256) + e * 8); curg = g; }
#pragma unroll
            for (int i = 0; i < 4; ++i) { const int tk = tid + 512 * i; const bf16_t* src = HN + (((size_t)b * 64 + g) * SEQ + tk) * 16;
                const u32x4 a = *(const u32x4*)src, c = *(const u32x4*)(src + 8); unsigned char* dst = Us + (tk >> 6) * 2080 + (tk & 63) * 32; *(u32x4*)dst = a; *(u32x4*)(dst + 16) = c; }
            __syncthreads();
            if (mode == 1) continue;
            {
                f32x16 acc;
#pragma unroll
                for (int i = 0; i < 16; ++i) acc[i] = 0.f;
                const int rb = w & 3, jh = w >> 2;
                const bf16_t* mp = ME + (size_t)g * (128 * 1024) + (size_t)((rb * 64 + 32 * jh) * 64 + lane) * 8;
                const unsigned char* up = Us + r * 2080 + 16 * half + 1024 * jh;
#pragma unroll 16
                for (int j = 0; j < 32; ++j) { const bf16x8 a = *(const bf16x8*)(mp + 512 * j); const bf16x8 bq = *(const bf16x8*)(up + j * 32); acc = MFMA32(a, bq, acc); }
#pragma unroll
                for (int i = 0; i < 16; ++i) Es[jh * 4096 + r * 128 + 32 * rb + (i & 3) + 8 * (i >> 2) + 4 * half] = acc[i];
            }
            __syncthreads();
            if (tid < 64) {
                const float lr = lam64[(g * 64 + tid) * 2], li = lam64[(g * 64 + tid) * 2 + 1]; float sr = 0.f, si = 0.f;
                float er[32], ei[32];
#pragma unroll
                for (int n = 0; n < 32; ++n) { er[n] = Es[n * 128 + tid] + Es[4096 + n * 128 + tid]; ei[n] = Es[n * 128 + 64 + tid] + Es[4096 + n * 128 + 64 + tid]; }
#pragma unroll
                for (int n = 0; n < 32; ++n) {
                    Ss[n * 136 + tid] = (bf16_t)(cvt_pk_bf16(sr, 0.f) & 0xffffu); Ss[n * 136 + 64 + tid] = (bf16_t)(cvt_pk_bf16(si, 0.f) & 0xffffu);
                    const float nr = lr * sr - li * si + er[n], ni = lr * si + li * sr + ei[n]; sr = nr; si = ni;
                }
            }
            __syncthreads();
            if (mode == 2) continue;
            f32x16 acc[4];
#pragma unroll
            for (int q = 0; q < 4; ++q)
#pragma unroll
                for (int i = 0; i < 16; ++i) acc[q][i] = 0.f;
            {
                const unsigned char* up = Us + r * 2080 + 16 * half;
                const bf16_t* kp = Ks + r * 16 + 8 * half;
                bf16x8 mya[4][4], myb[4][4];
#pragma unroll
                for (int ks = 0; ks < 4; ++ks)
#pragma unroll
                    for (int q = 0; q < 4; ++q) mya[ks][q] = *(const bf16x8*)(MY + (size_t)g * (1024 * 128) + (size_t)(((w + 8 * q) * 8 + ks) * 64 + lane) * 8);
#pragma unroll 2
                for (int j = 0; j < 64; ++j) {
                    const bf16x8 bq = *(const bf16x8*)(up + j * 32);
#pragma unroll
                    for (int q = 0; q < 4; ++q) { const int tbk = w + 8 * q; if (2 * tbk + 1 >= j) { const int d = 2 * tbk - j; const bf16x8 a = *(const bf16x8*)(kp + (d + 1) * 256); acc[q] = MFMA32(a, bq, acc[q]); } }
                }
#pragma unroll
                for (int ks = 0; ks < 4; ++ks)
#pragma unroll
                    for (int q = 0; q < 4; ++q) myb[ks][q] = *(const bf16x8*)(MY + (size_t)g * (1024 * 128) + (size_t)(((w + 8 * q) * 8 + 4 + ks) * 64 + lane) * 8);
                const bf16_t* sp = Ss + r * 136 + 8 * half;
#pragma unroll
                for (int ks = 0; ks < 4; ++ks) { const bf16x8 bq = *(const bf16x8*)(sp + 16 * ks);
#pragma unroll
                    for (int q = 0; q < 4; ++q) acc[q] = MFMA32(mya[ks][q], bq, acc[q]); }
#pragma unroll
                for (int ks = 0; ks < 4; ++ks) { const bf16x8 bq = *(const bf16x8*)(sp + 16 * (4 + ks));
#pragma unroll
                    for (int q = 0; q < 4; ++q) acc[q] = MFMA32(myb[ks][q], bq, acc[q]); }
            }
            if (mode == 3) { asm volatile("" :: "v"(acc[0][0]), "v"(acc[1][5]), "v"(acc[2][9]), "v"(acc[3][15])); continue; }
            __syncthreads();
#pragma unroll
            for (int q = 0; q < 4; ++q) {
                const int tbk = w + 8 * q;
#pragma unroll
                for (int gi = 0; gi < 4; ++gi) {
                    const int tl = 2 * tbk + (gi >> 1), cb = 8 * (gi & 1) + 4 * half;
                    unsigned char* lp_ = Us + r * 2080 + tl * 32 + cb * 2;
                    const u32x2 hv = *(const u32x2*)lp_;
                    const f32x4 dv = *(const f32x4*)(s5d + g * 16 + cb);
                    const float y0 = acc[q][4 * gi] + dv[0] * bf_lo(hv.x), y1 = acc[q][4 * gi + 1] + dv[1] * bf_hi(hv.x), y2 = acc[q][4 * gi + 2] + dv[2] * bf_lo(hv.y), y3 = acc[q][4 * gi + 3] + dv[3] * bf_hi(hv.y);
                    u32x2 o; o.x = cvt_pk_bf16(gelu_t(y0), gelu_t(y1)); o.y = cvt_pk_bf16(gelu_t(y2), gelu_t(y3));
                    *(u32x2*)lp_ = o;
                }
            }
            __syncthreads();
#pragma unroll
            for (int i = 0; i < 4; ++i) { const int tk = tid + 512 * i; bf16_t* dst = GBUF + ((size_t)b * SEQ + tk) * DM + g * 16;
                const unsigned char* src = Us + (tk >> 6) * 2080 + (tk & 63) * 32; *(u32x4*)dst = *(const u32x4*)src; *(u32x4*)(dst + 8) = *(const u32x4*)(src + 16); }
        }
}

struct EpiGlu {
    const bf16_t* GB; const float* bias; float* x; bf16_t* XB; float* sumsq; bool dry;
    static constexpr bool PERM = false, AFTER_DRAIN = false;
    __device__ __forceinline__ void operator()(const acc_t& acc, const pg8::Unit& u, int wr, int wc, int fr_, int fq_) const {
        const int pm = u.pm, pn = u.pn; int fr = fr_, fq = fq_; asm volatile("" : "+v"(fr), "+v"(fq));
#pragma unroll
        for (int ai = 0; ai < 2; ++ai) {
            u32x2 xr2[4][2][2], gr2[4][2][2];
#pragma unroll
            for (int m = 0; m < 4; ++m)
#pragma unroll
                for (int bj = 0; bj < 2; ++bj)
#pragma unroll
                    for (int n = 0; n < 2; ++n) { const size_t off = (size_t)(pm * 256 + ai * 128 + wr * 64 + m * 16 + fr) * DM + pn * 256 + bj * 128 + wc * 32 + n * 16 + fq * 4;
                        xr2[m][bj][n] = *(const u32x2*)((const bf16_t*)x + off); gr2[m][bj][n] = *(const u32x2*)(GB + off); }
#pragma unroll
            for (int m = 0; m < 4; ++m) {
                const int t = pm * 256 + ai * 128 + wr * 64 + m * 16 + fr; float ss = 0.f;
#pragma unroll
                for (int bj = 0; bj < 2; ++bj)
#pragma unroll
                    for (int n = 0; n < 2; ++n) {
                        const int col = pn * 256 + bj * 128 + wc * 32 + n * 16 + fq * 4; const size_t off = (size_t)t * DM + col;
                        const u32x2 xq2 = xr2[m][bj][n], gr = gr2[m][bj][n];
                        const f32x4 xv = (f32x4){bf_lo(xq2.x), bf_hi(xq2.x), bf_lo(xq2.y), bf_hi(xq2.y)}, bv = *(const f32x4*)(bias + col);
                        const f32x4 a = acc[ai][bj][m][n] + bv; f32x4 v;
                        v[0] = xv[0] + bf_lo(gr.x) * __builtin_amdgcn_rcpf(1.0f + __expf(-a[0])); v[1] = xv[1] + bf_hi(gr.x) * __builtin_amdgcn_rcpf(1.0f + __expf(-a[1]));
                        v[2] = xv[2] + bf_lo(gr.y) * __builtin_amdgcn_rcpf(1.0f + __expf(-a[2])); v[3] = xv[3] + bf_hi(gr.y) * __builtin_amdgcn_rcpf(1.0f + __expf(-a[3]));
                        u32x2 wv; wv.x = cvt_pk_bf16(v[0], v[1]); wv.y = cvt_pk_bf16(v[2], v[3]);
                        if (!dry) *(u32x2*)(XB + off) = wv;
                        ss += (v[0] * v[0] + v[1] * v[1]) + (v[2] * v[2] + v[3] * v[3]);
                    }
                ss += __shfl_xor(ss, 16); ss += __shfl_xor(ss, 32);
                if (fq == 0 && !dry) atomicAdd(sumsq + t, ss);
            }
            __builtin_amdgcn_sched_barrier(0);
        }
    }
};
typedef float f32x2 __attribute__((ext_vector_type(2)));
__device__ __forceinline__ void pro_table8(const float* __restrict__ src, const float* __restrict__ g, unsigned char* __restrict__ T8, float* __restrict__ S, int gw, int nw, int lane) {
    for (int e = gw; e < 16384; e += nw) {
        const float* rp = src + (size_t)e * DM + lane * 16; f32x4 v[4]; float mx = 0.f;
#pragma unroll
        for (int i = 0; i < 4; ++i) { v[i] = *(const f32x4*)(rp + 4 * i); if (g) v[i] = v[i] * *(const f32x4*)(g + lane * 16 + 4 * i);
            mx = fmaxf(mx, fmaxf(fmaxf(fabsf(v[i][0]), fabsf(v[i][1])), fmaxf(fabsf(v[i][2]), fabsf(v[i][3])))); }
#pragma unroll
        for (int o = 32; o > 0; o >>= 1) mx = fmaxf(mx, __shfl_xor(mx, o));
        const float s = mx > 0.f ? mx * (1.0f / 448.0f) : 1.0f, inv = 1.0f / s;
        u32x4 q;
#pragma unroll
        for (int i = 0; i < 4; ++i) { int w = __builtin_amdgcn_cvt_pk_fp8_f32(v[i][0] * inv, v[i][1] * inv, 0, false); w = __builtin_amdgcn_cvt_pk_fp8_f32(v[i][2] * inv, v[i][3] * inv, w, true); q[i] = (unsigned)w; }
        *(u32x4*)(T8 + (size_t)e * DM + lane * 16) = q;
        if (lane == 0) S[e] = s;
    }
}

template <int MODE>
__device__ __forceinline__ void phase_expert8(const bf16_t* __restrict__ XB, const float* __restrict__ sumsq, const int* __restrict__ idx, const float* __restrict__ gate,
                                              const unsigned char* __restrict__ Ut, const unsigned char* __restrict__ Vt, const float* __restrict__ SU, const float* __restrict__ SV,
                                              float* __restrict__ x, const float* __restrict__ gnext, bf16_t* __restrict__ XBout, int gw, int nw, int lane, bool dry) {
    const int pk = ((lane >> 5) & 1) * 4 + ((lane >> 4) & 1) * 2 + ((lane >> 3) & 1);
    for (int t0 = gw; t0 < T_TOK; t0 += nw) {
        const int t = __builtin_amdgcn_readfirstlane(t0);
        const u32x4 xa = *(const u32x4*)(XB + (size_t)t * DM + lane * 16), xb = *(const u32x4*)(XB + (size_t)t * DM + lane * 16 + 8);
        const f32x2 x2[8] = {{bf_lo(xa.x), bf_hi(xa.x)}, {bf_lo(xa.y), bf_hi(xa.y)}, {bf_lo(xa.z), bf_hi(xa.z)}, {bf_lo(xa.w), bf_hi(xa.w)},
                             {bf_lo(xb.x), bf_hi(xb.x)}, {bf_lo(xb.y), bf_hi(xb.y)}, {bf_lo(xb.z), bf_hi(xb.z)}, {bf_lo(xb.w), bf_hi(xb.w)}};
        const float rs = rsqrtf(sumsq[t] * (1.0f / DM) + 1e-6f);
        f32x2 y2[8];
#pragma unroll
        for (int i = 0; i < 8; ++i) y2[i] = (f32x2){0.f, 0.f};
#pragma unroll 1
        for (int grp = 0; grp < 16; ++grp) {
            const int* ip = idx + (size_t)t * 128 + grp * 8;
            int e[8];
#pragma unroll
            for (int k = 0; k < 8; ++k) e[k] = __builtin_amdgcn_readfirstlane(ip[k]);
            u32x4 uq[8], vq[8];
#pragma unroll
            for (int k = 0; k < 8; ++k) uq[k] = *(const u32x4*)(Ut + (size_t)e[k] * DM + lane * 16);
#pragma unroll
            for (int k = 0; k < 8; ++k) vq[k] = *(const u32x4*)(Vt + (size_t)e[k] * DM + lane * 16);
            const int emy = ip[pk]; const float wsc = gate[(size_t)t * 128 + grp * 8 + pk] * SV[emy], usc = SU[emy] * rs;
            float d[8];
#pragma unroll
            for (int k = 0; k < 8; ++k) {
                f32x2 a0 = (f32x2){0.f, 0.f}, a1 = (f32x2){0.f, 0.f};
#pragma unroll
                for (int i = 0; i < 4; ++i) {
                    a0 = __builtin_elementwise_fma(__builtin_amdgcn_cvt_pk_f32_fp8((int)uq[k][i], false), x2[2 * i], a0);
                    a1 = __builtin_elementwise_fma(__builtin_amdgcn_cvt_pk_f32_fp8((int)uq[k][i], true), x2[2 * i + 1], a1);
                }
                d[k] = (a0.x + a0.y) + (a1.x + a1.y);
            }
            float r4[4], r2[2], r1;
            { const bool hi = (lane & 32) != 0;
#pragma unroll
              for (int i = 0; i < 4; ++i) { const float keep = hi ? d[i + 4] : d[i], send = hi ? d[i] : d[i + 4]; r4[i] = keep + __shfl_xor(send, 32); } }
            { const bool hi = (lane & 16) != 0;
#pragma unroll
              for (int i = 0; i < 2; ++i) { const float keep = hi ? r4[i + 2] : r4[i], send = hi ? r4[i] : r4[i + 2]; r2[i] = keep + __shfl_xor(send, 16); } }
            { const bool hi = (lane & 8) != 0; const float keep = hi ? r2[1] : r2[0], send = hi ? r2[0] : r2[1]; r1 = keep + __shfl_xor(send, 8); }
            r1 += __shfl_xor(r1, 4); r1 += __shfl_xor(r1, 2); r1 += __shfl_xor(r1, 1);
            const float wgt = wsc * gelu_t(r1 * usc);
#pragma unroll
            for (int k = 0; k < 8; ++k) {
                const float wk = __uint_as_float(__builtin_amdgcn_readlane(__float_as_uint(wgt), ((k >> 2) & 1) * 32 + ((k >> 1) & 1) * 16 + (k & 1) * 8));
                const f32x2 w2 = (f32x2){wk, wk};
#pragma unroll
                for (int i = 0; i < 4; ++i) {
                    y2[2 * i] = __builtin_elementwise_fma(__builtin_amdgcn_cvt_pk_f32_fp8((int)vq[k][i], false), w2, y2[2 * i]);
                    y2[2 * i + 1] = __builtin_elementwise_fma(__builtin_amdgcn_cvt_pk_f32_fp8((int)vq[k][i], true), w2, y2[2 * i + 1]);
                }
            }
        }
        if (dry) continue;
        float* xr = x + (size_t)t * DM + lane * 16; float ss = 0.f; f32x4 xn[4];
#pragma unroll
        for (int i = 0; i < 4; ++i) { const f32x4 xv = *(const f32x4*)(xr + 4 * i); xn[i] = xv + (f32x4){y2[2 * i].x, y2[2 * i].y, y2[2 * i + 1].x, y2[2 * i + 1].y};
            ss += (xn[i][0] * xn[i][0] + xn[i][1] * xn[i][1]) + (xn[i][2] * xn[i][2] + xn[i][3] * xn[i][3]); }
        ss = wave_sum(ss); const float rn = rsqrtf(ss * (1.0f / DM) + 1e-6f);
        if (MODE == 0) {
            u32x4 o[2];
#pragma unroll
            for (int i = 0; i < 4; ++i) { *(f32x4*)(xr + 4 * i) = xn[i]; const f32x4 gv = *(const f32x4*)(gnext + lane * 16 + 4 * i); const f32x4 r = xn[i] * gv * rn;
                const unsigned a = cvt_pk_bf16(r[0], r[1]), b = cvt_pk_bf16(r[2], r[3]);
                if ((i & 1) == 0) { o[i >> 1].x = a; o[i >> 1].y = b; } else { o[i >> 1].z = a; o[i >> 1].w = b; } }
            *(u32x4*)(XBout + (size_t)t * DM + lane * 16) = o[0]; *(u32x4*)(XBout + (size_t)t * DM + lane * 16 + 8) = o[1];
        } else {
#pragma unroll
            for (int i = 0; i < 4; ++i) { const f32x4 gv = *(const f32x4*)(gnext + lane * 16 + 4 * i); *(f32x4*)(xr + 4 * i) = xn[i] * gv * rn; }
        }
    }
}
typedef int v6i __attribute__((ext_vector_type(6)));
typedef float v32f __attribute__((ext_vector_type(32)));
typedef float v16f __attribute__((ext_vector_type(16)));
#define ROW6 768
__device__ __forceinline__ void pro_table6(const float* __restrict__ src, const float* __restrict__ g, unsigned char* __restrict__ T6, float* __restrict__ S, int gw, int nw, int lane) {
    const int lp = lane & 31, hf = lane >> 5;
    for (int e0 = gw * 4; e0 < 16384; e0 += nw * 4) {
        v16f a[2], b[2]; float mx[2];
#pragma unroll
        for (int u = 0; u < 2; ++u) {
            const float* rp = src + (size_t)(e0 + 2 * u + hf) * DM + lp * 32;
#pragma unroll
            for (int i = 0; i < 4; ++i) { const f32x4 v = *(const f32x4*)(rp + 4 * i); a[u][4 * i] = v[0]; a[u][4 * i + 1] = v[1]; a[u][4 * i + 2] = v[2]; a[u][4 * i + 3] = v[3]; }
#pragma unroll
            for (int i = 0; i < 4; ++i) { const f32x4 v = *(const f32x4*)(rp + 16 + 4 * i); b[u][4 * i] = v[0]; b[u][4 * i + 1] = v[1]; b[u][4 * i + 2] = v[2]; b[u][4 * i + 3] = v[3]; }
        }
        if (g) {
#pragma unroll
            for (int i = 0; i < 4; ++i) { const f32x4 g0 = *(const f32x4*)(g + lp * 32 + 4 * i), g1 = *(const f32x4*)(g + lp * 32 + 16 + 4 * i);
#pragma unroll
                for (int u = 0; u < 2; ++u) { a[u][4 * i] *= g0[0]; a[u][4 * i + 1] *= g0[1]; a[u][4 * i + 2] *= g0[2]; a[u][4 * i + 3] *= g0[3];
                    b[u][4 * i] *= g1[0]; b[u][4 * i + 1] *= g1[1]; b[u][4 * i + 2] *= g1[2]; b[u][4 * i + 3] *= g1[3]; } }
        }
#pragma unroll
        for (int u = 0; u < 2; ++u) { mx[u] = 0.f;
#pragma unroll
            for (int i = 0; i < 16; ++i) mx[u] = fmaxf(mx[u], fmaxf(fabsf(a[u][i]), fabsf(b[u][i]))); }
#pragma unroll
        for (int o = 16; o > 0; o >>= 1) { mx[0] = fmaxf(mx[0], __shfl_xor(mx[0], o)); mx[1] = fmaxf(mx[1], __shfl_xor(mx[1], o)); }
#pragma unroll
        for (int u = 0; u < 2; ++u) {
            const int e = e0 + 2 * u + hf;
            const float s = mx[u] > 0.f ? mx[u] * (1.0f / 7.5f) : 1.0f, inv = 1.0f / s;
            v16f ev, od;
#pragma unroll
            for (int i = 0; i < 8; ++i) { ev[i] = a[u][2 * i] * inv; od[i] = a[u][2 * i + 1] * inv; ev[8 + i] = b[u][2 * i] * inv; od[8 + i] = b[u][2 * i + 1] * inv; }
            const v6i q = __builtin_amdgcn_cvt_scalef32_2xpk16_fp6_f32(ev, od, 1.0f);
            unsigned char* row = T6 + (size_t)e * ROW6;
            *(u32x4*)(row + 16 * lp) = (u32x4){(unsigned)q[0], (unsigned)q[1], (unsigned)q[2], (unsigned)q[3]};
            *(u32x2*)(row + 512 + 8 * lp) = (u32x2){(unsigned)q[4], (unsigned)q[5]};
            if (lp == 0) S[e] = s;
        }
    }
}

template <int MODE>
__device__ __forceinline__ void phase_expert6(const bf16_t* __restrict__ XB, const float* __restrict__ sumsq, const int* __restrict__ idx, const float* __restrict__ gate,
                                              const unsigned char* __restrict__ Ut, const unsigned char* __restrict__ Vt, const float* __restrict__ SU, const float* __restrict__ SV,
                                              float* __restrict__ x, const float* __restrict__ gnext, bf16_t* __restrict__ XBout, int gw, int nw, int lane__, bool dry) {
    const int lane = lane__;
    for (int t0 = gw; t0 < T_TOK; t0 += nw) {
        int lane_ = lane; asm volatile("" : "+v"(lane_));
        const int lane = lane_, lp = lane & 31, hf = lane >> 5;
        const int myslot = ((lane >> 4) & 1) * 2 + ((lane >> 3) & 1);
        const int t = __builtin_amdgcn_readfirstlane(t0);
        float xf[32];
        { const bf16_t* xp = XB + (size_t)t * DM + lp * 32;
#pragma unroll
          for (int i = 0; i < 4; ++i) { const u32x4 r = *(const u32x4*)(xp + 8 * i);
              xf[8 * i] = bf_lo(r.x); xf[8 * i + 1] = bf_hi(r.x); xf[8 * i + 2] = bf_lo(r.y); xf[8 * i + 3] = bf_hi(r.y);
              xf[8 * i + 4] = bf_lo(r.z); xf[8 * i + 5] = bf_hi(r.z); xf[8 * i + 6] = bf_lo(r.w); xf[8 * i + 7] = bf_hi(r.w); } }
        const float rs = rsqrtf(sumsq[t] * (1.0f / DM) + 1e-6f);
        float y[32];
#pragma unroll
        for (int i = 0; i < 32; ++i) y[i] = 0.f;
#pragma unroll 1
        for (int grp = 0; grp < 16; ++grp) {
            const int* ip = idx + (size_t)t * 128 + grp * 8;
            u32x4 u4[4], v4[4]; u32x2 u2[4], v2[4];
#pragma unroll
            for (int k = 0; k < 4; ++k) { const int e = ip[2 * k + hf]; const unsigned char* ur = Ut + (size_t)e * ROW6; u4[k] = *(const u32x4*)(ur + 16 * lp); u2[k] = *(const u32x2*)(ur + 512 + 8 * lp); }
#pragma unroll
            for (int k = 0; k < 4; ++k) { const int e = ip[2 * k + hf]; const unsigned char* vr = Vt + (size_t)e * ROW6; v4[k] = *(const u32x4*)(vr + 16 * lp); v2[k] = *(const u32x2*)(vr + 512 + 8 * lp); }
            const int mypick = 2 * myslot + hf; const int emy = ip[mypick];
            const float wsc = gate[(size_t)t * 128 + grp * 8 + mypick] * SV[emy], usc = SU[emy] * rs;
            float d[4];
#pragma unroll
            for (int k = 0; k < 4; ++k) {
                const v6i w = {(int)u4[k].x, (int)u4[k].y, (int)u4[k].z, (int)u4[k].w, (int)u2[k].x, (int)u2[k].y};
                const v32f r = __builtin_amdgcn_cvt_scalef32_pk32_f32_fp6(w, 1.0f);
                float s0 = 0.f, s1 = 0.f, s2 = 0.f, s3 = 0.f;
#pragma unroll
                for (int i = 0; i < 8; ++i) { s0 += r[4 * i] * xf[4 * i]; s1 += r[4 * i + 1] * xf[4 * i + 1]; s2 += r[4 * i + 2] * xf[4 * i + 2]; s3 += r[4 * i + 3] * xf[4 * i + 3]; }
                d[k] = (s0 + s1) + (s2 + s3);
            }
            float r2[2], r1;
            { const bool hi = (lane & 16) != 0;
#pragma unroll
              for (int i = 0; i < 2; ++i) { const float keep = hi ? d[i + 2] : d[i], send = hi ? d[i] : d[i + 2]; r2[i] = keep + __shfl_xor(send, 16); } }
            { const bool hi = (lane & 8) != 0; const float keep = hi ? r2[1] : r2[0], send = hi ? r2[0] : r2[1]; r1 = keep + __shfl_xor(send, 8); }
            r1 += __shfl_xor(r1, 4); r1 += __shfl_xor(r1, 2); r1 += __shfl_xor(r1, 1);
            const float wgt = wsc * gelu_t(r1 * usc);
#pragma unroll
            for (int k = 0; k < 4; ++k) {
                const int sl = ((k >> 1) & 1) * 16 + (k & 1) * 8;
                const float wlo = __uint_as_float(__builtin_amdgcn_readlane(__float_as_uint(wgt), sl)), whi = __uint_as_float(__builtin_amdgcn_readlane(__float_as_uint(wgt), 32 + sl));
                const float wk = hf ? whi : wlo;
                const v6i w = {(int)v4[k].x, (int)v4[k].y, (int)v4[k].z, (int)v4[k].w, (int)v2[k].x, (int)v2[k].y};
                const v32f r = __builtin_amdgcn_cvt_scalef32_pk32_f32_fp6(w, 1.0f);
#pragma unroll
                for (int i = 0; i < 32; ++i) y[i] += wk * r[i];
            }
        }
        float yo[16];
#pragma unroll
        for (int i = 0; i < 16; ++i) { const float mine = hf ? y[16 + i] : y[i], other = hf ? y[i] : y[16 + i]; yo[i] = mine + __shfl_xor(other, 32); }
        if (dry) continue;
        float* xr = x + (size_t)t * DM + lp * 32 + hf * 16; float ss = 0.f; f32x4 xn[4];
#pragma unroll
        for (int i = 0; i < 4; ++i) { const f32x4 xv = *(const f32x4*)(xr + 4 * i); xn[i] = xv + (f32x4){yo[4 * i], yo[4 * i + 1], yo[4 * i + 2], yo[4 * i + 3]};
            ss += (xn[i][0] * xn[i][0] + xn[i][1] * xn[i][1]) + (xn[i][2] * xn[i][2] + xn[i][3] * xn[i][3]); }
        ss = wave_sum(ss); const float rn = rsqrtf(ss * (1.0f / DM) + 1e-6f);
        const float* gp = gnext + lp * 32 + hf * 16;
        if (MODE == 0) {
            u32x4 o[2];
#pragma unroll
            for (int i = 0; i < 4; ++i) { *(f32x4*)(xr + 4 * i) = xn[i]; const f32x4 gv = *(const f32x4*)(gp + 4 * i); const f32x4 r = xn[i] * gv * rn;
                const unsigned a = cvt_pk_bf16(r[0], r[1]), b = cvt_pk_bf16(r[2], r[3]);
                if ((i & 1) == 0) { o[i >> 1].x = a; o[i >> 1].y = b; } else { o[i >> 1].z = a; o[i >> 1].w = b; } }
            bf16_t* xo = XBout + (size_t)t * DM + lp * 32 + hf * 16;
            *(u32x4*)xo = o[0]; *(u32x4*)(xo + 8) = o[1];
        } else {
#pragma unroll
            for (int i = 0; i < 4; ++i) { const f32x4 gv = *(const f32x4*)(gp + 4 * i); *(f32x4*)(xr + 4 * i) = xn[i] * gv * rn; }
        }
    }
}
#define EXP_RING_BYTES 18432
__device__ __forceinline__ int laneid_opaque() { int z = 0; asm volatile("" : "+v"(z)); return (int)__builtin_amdgcn_mbcnt_hi(~0u, __builtin_amdgcn_mbcnt_lo(~0u, (unsigned)z)); }
typedef unsigned v16u __attribute__((ext_vector_type(16)));
typedef __bf16 v32bf __attribute__((ext_vector_type(32)));
typedef _Float16 v32h __attribute__((ext_vector_type(32)));
typedef _Float16 h2 __attribute__((ext_vector_type(2)));
template <int MODE>
__device__ __forceinline__ void phase_expert6d(const bf16_t* __restrict__ XB, const float* __restrict__ sumsq, const int* __restrict__ idx, const float* __restrict__ gate,
                                               const unsigned char* __restrict__ Ut, const unsigned char* __restrict__ Vt, const float* __restrict__ SU, const float* __restrict__ SV,
                                               float* __restrict__ x, const float* __restrict__ gnext, bf16_t* __restrict__ XBout, unsigned char* smem, int nblk, bool dry, int emode) {
    const int wid = __builtin_amdgcn_readfirstlane(threadIdx.x >> 6), gw = blockIdx.x * 8 + wid, nw = nblk * 8;
    LAS unsigned char* RB = (LAS unsigned char*)smem + wid * EXP_RING_BYTES;
    for (int pr = gw; pr < T_TOK / 2; pr += nw) {
        const int lane = laneid_opaque(), lp = lane & 31, hf = lane >> 5;
        const int myslot = ((lane >> 4) & 1) * 2 + ((lane >> 3) & 1);
        const int t = 2 * pr + hf;
        unsigned key[4];
#pragma unroll
        for (int q = 0; q < 4; ++q) { const int pk = 32 * q + lp; key[q] = ((unsigned)idx[(size_t)t * 128 + pk] << 7) | (unsigned)pk; }
        unsigned xq[16];
        { const bf16_t* xp = XB + (size_t)t * DM + lp * 32;
#pragma unroll
          for (int i = 0; i < 4; ++i) { const u32x4 r = *(const u32x4*)(xp + 8 * i); xq[4 * i] = r.x; xq[4 * i + 1] = r.y; xq[4 * i + 2] = r.z; xq[4 * i + 3] = r.w; } }
        const float rs = rsqrtf(sumsq[t] * (1.0f / DM) + 1e-6f);
#pragma unroll
        for (int k = 2; k <= 128; k <<= 1)
#pragma unroll
            for (int j = k >> 1; j >= 1; j >>= 1) {
                if (j >= 32) {
                    const int dq = j >> 5;
#pragma unroll
                    for (int q = 0; q < 4; ++q) if ((q & dq) == 0) {
                        const bool asc = k == 128 ? true : (((32 * q) & k) == 0);
                        const unsigned lo = min(key[q], key[q | dq]), hi = max(key[q], key[q | dq]);
                        key[q] = asc ? lo : hi; key[q | dq] = asc ? hi : lo;
                    }
                } else {
#pragma unroll
                    for (int q = 0; q < 4; ++q) {
                        const unsigned other = (unsigned)__shfl_xor((int)key[q], j);
                        const int s = 32 * q + lp; const bool asc = (s & k) == 0, lower = (lp & j) == 0;
                        const unsigned lo = min(key[q], other), hi = max(key[q], other);
                        key[q] = (asc == lower) ? lo : hi;
                    }
                }
            }
        int ide[4];
        LAS unsigned* MT = (LAS unsigned*)((LAS unsigned char*)smem + 8 * EXP_RING_BYTES + wid * 1024) + hf * 128;
#pragma unroll
        for (int q = 0; q < 4; ++q) { ide[q] = (int)(key[q] >> 7); const int pk = (int)(key[q] & 127u);
            MT[32 * q + lp] = cvt_pk_bf16(SU[ide[q]] * rs, gate[(size_t)t * 128 + pk] * SV[ide[q]]); }
        h2 yh[16];
#pragma unroll
        for (int i = 0; i < 16; ++i) yh[i] = (h2){(_Float16)0.f, (_Float16)0.f};
        asm volatile("s_waitcnt vmcnt(0)" ::: "memory");
        int pl_[6], po_[6];
#pragma unroll
        for (int _i = 0; _i < 6; ++_i) { const int _byte = 1024 * _i + 16 * lane, _r = (_byte * 683) >> 19; po_[_i] = _byte - 768 * _r; pl_[_i] = 32 * (_r & 1) + (_r >> 1); }
        int ido[4];
#pragma unroll
        for (int q = 0; q < 4; ++q) ido[q] = ide[q] * ROW6;
#define EXP_ADDR(A, HG) do { const int _g = (HG) >> 1; const int _idr = (_g < 8) ? ido[0] : ((_g < 16) ? ido[1] : ((_g < 24) ? ido[2] : ido[3])); \
            _Pragma("unroll") for (int _i = 0; _i < 6; ++_i) A[_i] = __shfl(_idr, (pl_[_i] & 32) + ((4 * _g + pl_[_i]) & 31)) + po_[_i]; } while (0)
#define EXP_DMA(A, HG) do { const int _hg = (HG); const unsigned char* _tab = (_hg & 1) ? Vt : Ut; LAS unsigned char* _dst = RB + (_hg % 3) * 6144; \
            _Pragma("unroll") for (int _i = 0; _i < 6; ++_i) __builtin_amdgcn_global_load_lds((const unsigned*)(_tab + (unsigned)A[_i]), (LAS unsigned*)(_dst + 1024 * _i), 16, 0, 0); } while (0)
#define EXP_ISSUE(HG) do { int _a[6]; EXP_ADDR(_a, HG); EXP_DMA(_a, HG); } while (0)
        { int a0_[6], a1_[6]; EXP_ADDR(a0_, 0); EXP_ADDR(a1_, 1); EXP_DMA(a0_, 0); EXP_DMA(a1_, 1); }
#pragma unroll 1
        for (int g = 0; g < 32; ++g) {
            if (g < 31) { EXP_ISSUE(2 * g + 2); asm volatile("s_waitcnt vmcnt(12)" ::: "memory"); } else { asm volatile("s_waitcnt vmcnt(6)" ::: "memory"); }
            float wgt;
            {
                const LAS unsigned char* bu = RB + ((2 * g) % 3) * 6144 + hf * 768 + 16 * lp;
                float d[4] = {0.f, 0.f, 0.f, 0.f};
                if (emode < 2)
#pragma unroll
                for (int k = 0; k < 4; ++k) {
                    const u32x4 q4 = *(const LAS u32x4*)(bu + k * 1536); const u32x2 q2 = *(const LAS u32x2*)(bu + k * 1536 + 512 - 8 * lp);
                    const v6i w = {(int)q4.x, (int)q4.y, (int)q4.z, (int)q4.w, (int)q2.x, (int)q2.y};
                    const v16u r = __builtin_bit_cast(v16u, __builtin_amdgcn_cvt_scalef32_pk32_bf16_fp6(w, 1.0f));
                    float s0 = 0.f, s1 = 0.f, s2 = 0.f, s3 = 0.f;
#pragma unroll
                    for (int i = 0; i < 4; ++i) { s0 = dot2bf(r[4 * i], xq[4 * i], s0); s1 = dot2bf(r[4 * i + 1], xq[4 * i + 1], s1); s2 = dot2bf(r[4 * i + 2], xq[4 * i + 2], s2); s3 = dot2bf(r[4 * i + 3], xq[4 * i + 3], s3); }
                    d[k] = (s0 + s1) + (s2 + s3);
                }
                float r2[2], r1;
#pragma unroll
                for (int i = 0; i < 2; ++i) { const auto sw = __builtin_amdgcn_permlane16_swap(__float_as_uint(d[i]), __float_as_uint(d[i + 2]), false, false); r2[i] = __uint_as_float(sw[0]) + __uint_as_float(sw[1]); }
                { const bool hi = (lane & 8) != 0; const float keep = hi ? r2[1] : r2[0], send = hi ? r2[0] : r2[1];
                  r1 = keep + __uint_as_float((unsigned)__builtin_amdgcn_update_dpp(0, (int)__float_as_uint(send), 0x128  , 0xf, 0xf, true)); }
                r1 += __uint_as_float((unsigned)__builtin_amdgcn_update_dpp(0, (int)__float_as_uint(r1), 0x141  , 0xf, 0xf, true));
                r1 += __uint_as_float((unsigned)__builtin_amdgcn_update_dpp(0, (int)__float_as_uint(r1), 0x4E  , 0xf, 0xf, true));
                r1 += __uint_as_float((unsigned)__builtin_amdgcn_update_dpp(0, (int)__float_as_uint(r1), 0xB1  , 0xf, 0xf, true));
                const unsigned mt = MT[4 * g + myslot];
                wgt = bf_hi(mt) * gelu_t(r1 * bf_lo(mt));
            }
            if (g < 31) { EXP_ISSUE(2 * g + 3); asm volatile("s_waitcnt vmcnt(12)" ::: "memory"); } else { asm volatile("s_waitcnt vmcnt(0)" ::: "memory"); }
            {
                const LAS unsigned char* bv = RB + ((2 * g + 1) % 3) * 6144 + hf * 768 + 16 * lp;
                if (emode < 1)
#pragma unroll
                for (int k = 0; k < 4; ++k) {
                    const int sl = ((k >> 1) & 1) * 16 + (k & 1) * 8;
                    const float wlo = __uint_as_float(__builtin_amdgcn_readlane(__float_as_uint(wgt), sl)), whi = __uint_as_float(__builtin_amdgcn_readlane(__float_as_uint(wgt), 32 + sl));
                    const float wk = hf ? whi : wlo;
                    const u32x4 q4 = *(const LAS u32x4*)(bv + k * 1536); const u32x2 q2 = *(const LAS u32x2*)(bv + k * 1536 + 512 - 8 * lp);
                    const v6i w = {(int)q4.x, (int)q4.y, (int)q4.z, (int)q4.w, (int)q2.x, (int)q2.y};
                    const v32h r = __builtin_amdgcn_cvt_scalef32_pk32_f16_fp6(w, 1.0f);
                    const h2 w2 = (h2){(_Float16)wk, (_Float16)wk};
#pragma unroll
                    for (int i = 0; i < 16; ++i) yh[i] = __builtin_elementwise_fma((h2){r[2 * i], r[2 * i + 1]}, w2, yh[i]);
                }
            }
        }
#undef EXP_ISSUE
#undef EXP_ADDR
#undef EXP_DMA
        if (dry) continue;
        float y[32];
#pragma unroll
        for (int i = 0; i < 16; ++i) { y[2 * i] = (float)yh[i].x; y[2 * i + 1] = (float)yh[i].y; }
        float* xr = x + (size_t)t * DM + lp * 32; float ss = 0.f;
#pragma unroll
        for (int i = 0; i < 8; ++i) { y[4 * i] += bf_lo(xq[2 * i]); y[4 * i + 1] += bf_hi(xq[2 * i]); y[4 * i + 2] += bf_lo(xq[2 * i + 1]); y[4 * i + 3] += bf_hi(xq[2 * i + 1]);
            ss += (y[4 * i] * y[4 * i] + y[4 * i + 1] * y[4 * i + 1]) + (y[4 * i + 2] * y[4 * i + 2] + y[4 * i + 3] * y[4 * i + 3]); }
#pragma unroll
        for (int o = 16; o > 0; o >>= 1) ss += __shfl_xor(ss, o);
        const float rn = rsqrtf(ss * (1.0f / DM) + 1e-6f);
        const float* gp = gnext + lp * 32;
        if (MODE == 0) {
            bf16_t* xo = XBout + (((size_t)(t >> 11) * 64 + 2 * lp) * SEQ + (t & 2047)) * 16;
#pragma unroll
            for (int i = 0; i < 4; ++i) {
                { u32x4 xr16; xr16.x = cvt_pk_bf16(y[8 * i], y[8 * i + 1]); xr16.y = cvt_pk_bf16(y[8 * i + 2], y[8 * i + 3]); xr16.z = cvt_pk_bf16(y[8 * i + 4], y[8 * i + 5]); xr16.w = cvt_pk_bf16(y[8 * i + 6], y[8 * i + 7]);
                  *(u32x4*)((bf16_t*)x + (size_t)t * DM + lp * 32 + 8 * i) = xr16; }
                const f32x4 g0 = *(const f32x4*)(gp + 8 * i), g1 = *(const f32x4*)(gp + 8 * i + 4);
                u32x4 o; o.x = cvt_pk_bf16(y[8 * i] * g0[0] * rn, y[8 * i + 1] * g0[1] * rn); o.y = cvt_pk_bf16(y[8 * i + 2] * g0[2] * rn, y[8 * i + 3] * g0[3] * rn);
                o.z = cvt_pk_bf16(y[8 * i + 4] * g1[0] * rn, y[8 * i + 5] * g1[1] * rn); o.w = cvt_pk_bf16(y[8 * i + 6] * g1[2] * rn, y[8 * i + 7] * g1[3] * rn);
                *(u32x4*)(xo + (size_t)(i >> 1) * (SEQ * 16) + 8 * (i & 1)) = o;
            }
        } else {
#pragma unroll
            for (int i = 0; i < 8; ++i) { const f32x4 gv = *(const f32x4*)(gp + 4 * i); *(f32x4*)(xr + 4 * i) = (f32x4){y[4 * i] * gv[0] * rn, y[4 * i + 1] * gv[1] * rn, y[4 * i + 2] * gv[2] * rn, y[4 * i + 3] * gv[3] * rn}; }
        }
    }
}
typedef const __attribute__((address_space(4))) P* PK;
#define LDS_XST (147456 + 8192)
#define LDS_TOTAL (147456 + 8192 + 16)
__global__ void __launch_bounds__(512) mega(P p_) {
#if defined(__HIP_DEVICE_COMPILE__)
    extern __shared__ __attribute__((aligned(16))) unsigned char smem[];
    cg::grid_group grid = cg::this_grid();
    const int ph_lo = p_.ph_lo, ph_hi = p_.ph_hi;
    volatile LAS unsigned* xst = (volatile LAS unsigned*)(smem + LDS_XST);
    if (threadIdx.x == 0) { xst[0] = 0u; xst[1] = 0u; }
    __syncthreads();
    const XcdBarrier xb = xcd_barrier_post((unsigned*)(p_.ws + WS_BAR), xst);
    const int rep_ph = p_.rep_ph, rep_n = p_.rep_n;
#ifndef PROBE_REPLAY_K
#define PROBE_REPLAY_K -1
#endif
    for (int pass = 0; pass < (PROBE_REPLAY_K >= 0 ? 2 : 1); ++pass)
    for (int ph = ph_lo; ph <= (pass == 0 ? ph_hi : PROBE_REPLAY_K); ++ph) {
        if (ph == 5 || ph == 10) continue;
#if PROBE_REP_N > 1
        const int reps = (ph == rep_ph && rep_n > 1) ? rep_n : 1;
        for (int rep = 0; rep < reps; ++rep) {
        const bool dry = rep > 0;
#else
        {
        const bool dry = PROBE_REPLAY_K >= 0 ? (pass > 0) : false;
#endif
        const int ph_outer = ph; int ph = ph_outer; asm volatile("" : "+s"(ph));
        PK pk = (PK)__builtin_amdgcn_kernarg_segment_ptr(); asm volatile("" : "+s"(pk));
        const P p = *pk;
        unsigned char* ws = p.ws;
        bf16_t* XB = (bf16_t*)(ws + WS_XB);
        int nb_ = gridDim.x; asm volatile("" : "+s"(nb_));
#define PH_IDS int tid_ = threadIdx.x; asm volatile("" : "+v"(tid_)); const int tid = tid_, lane = tid & 63, gw = blockIdx.x * 8 + (tid >> 6), nw = nb_ * 8, gtid = blockIdx.x * 512 + tid, nthr = nb_ * 512; (void)lane; (void)gw; (void)nw; (void)gtid; (void)nthr;
        if (ph == 0) { PH_IDS
            const int pm0 = dry ? PROBE_S5_MODE : 0;
            if (pm0 == 0) {
                const int wv = tid >> 6, nblk_ = nb_;
                if (wv < 4) {
                    const int rgw = blockIdx.x * 4 + wv, rnw = nblk_ * 4;
                    for (int l = 0; l < 2; ++l) {
                        pro_table6(p.pu + (size_t)l * 16384 * 1024, p.norm_ffn_g + l * DM, ws + WS_UTAB + MB(12) * l, (float*)(ws + WS_SU) + l * 16384, rgw, rnw, lane);
                        pro_table6(p.pv + (size_t)l * 16384 * 1024, nullptr, ws + WS_VTAB + MB(12) * l, (float*)(ws + WS_SV) + l * 16384, rgw, rnw, lane);
                    }
                } else if (wv < 7) {
                    pro_rmsnorm_rows(p.x, p.norm_mix_g, XB, blockIdx.x * 3 + (wv - 4), nblk_ * 3, lane);
                } else {
                    const int rt = blockIdx.x * 64 + lane, rn = nblk_ * 64;
                    pro_transpose<true>(p.w_in, 2560, nullptr, (bf16_t*)(ws + WS_WTIN), rt, rn);
                    pro_transpose<false>(p.w_out, 1024, nullptr, (bf16_t*)(ws + WS_WTOUT), rt, rn);
                    pro_transpose<false>(p.glu_w, 1024, nullptr, (bf16_t*)(ws + WS_WTGLU), rt, rn);
                }
                pro_wqk(p.wq, p.subkeys, p.norm_ffn_g, (bf16_t*)(ws + WS_WQK), gw, nw, lane);
            }
            if (pm0 == 1) {
            pro_rmsnorm_rows(p.x, p.norm_mix_g, XB, gw, nw, lane);
            pro_transpose<true>(p.w_in, 2560, nullptr, (bf16_t*)(ws + WS_WTIN), gtid, nthr);
            pro_transpose<false>(p.w_out, 1024, nullptr, (bf16_t*)(ws + WS_WTOUT), gtid, nthr);
            pro_wqk(p.wq, p.subkeys, p.norm_ffn_g, (bf16_t*)(ws + WS_WQK), gw, nw, lane);
            pro_transpose<false>(p.glu_w, 1024, nullptr, (bf16_t*)(ws + WS_WTGLU), gtid, nthr);
            }
            if (pm0 == 2)
            for (int l = 0; l < 2; ++l) {
                pro_table6(p.pu + (size_t)l * 16384 * 1024, p.norm_ffn_g + l * DM, ws + WS_UTAB + MB(12) * l, (float*)(ws + WS_SU) + l * 16384, gw, nw, lane);
                pro_table6(p.pv + (size_t)l * 16384 * 1024, nullptr, ws + WS_VTAB + MB(12) * l, (float*)(ws + WS_SV) + l * 16384, gw, nw, lane);
            }
            if (pm0 == 0 || pm0 == 3)
            pro_s5(p.lam_re, p.lam_im, p.b_re, p.b_im, p.c_re, p.c_im, p.log_step, (bf16_t*)(ws + WS_KTAB), (bf16_t*)(ws + WS_ME), (bf16_t*)(ws + WS_MY), (float*)(ws + WS_LAM64), smem, tid);
            if (pm0 != 0) {
            } else {
            float* ssa = (float*)(ws + WS_SSA);
            for (int i = gtid; i < 2 * T_TOK; i += nthr) ssa[i] = 0.f;
            }
        } else if (ph == 1) {
            EpiIn e{(bf16_t*)(ws + WS_Q), (bf16_t*)(ws + WS_K), (bf16_t*)(ws + WS_VT), (bf16_t*)(ws + WS_UG), (bf16_t*)(ws + WS_GG)};
            pg8::Gemm g{XB, (const bf16_t*)(ws + WS_WTIN), T_TOK, 2560, 1024}; pg8::StaticOrder S; S.init(T_TOK, 2560, gridDim.x, blockIdx.x);
            pg8::gemm_phase<EpiIn, pg8::StaticOrder, true, true>((PG8_LAS unsigned char*)smem, g, S, e);
        } else if (ph == 2) { PH_IDS
            for (int r2 = 0; r2 < ((p.rep_ph == 20 && p.rep_n > 1) ? p.rep_n : 1); ++r2)
                phase_attn((const bf16_t*)(ws + WS_Q), (const bf16_t*)(ws + WS_K), (const bf16_t*)(ws + WS_VT), (bf16_t*)(ws + WS_MIXB), gw, nw, lane);
            for (int r2 = 0; r2 < ((p.rep_ph == 21 && p.rep_n > 1) ? p.rep_n : 1); ++r2)
                phase_sgu((const bf16_t*)(ws + WS_UG), (const bf16_t*)(ws + WS_GG), p.sgu_norm_g, p.sgu_w, p.sgu_b, (bf16_t*)(ws + WS_MIXB), smem);
        } else if (ph == 3) {
            EpiRes e{p.x, p.out, XB, (float*)(ws + WS_SSA), dry};
            pg8::Gemm g{(const bf16_t*)(ws + WS_MIXB), (const bf16_t*)(ws + WS_WTOUT), T_TOK, 1024, 1024}; pg8::StaticOrder S; S.init(T_TOK, 1024, gridDim.x, blockIdx.x);
            pg8::gemm_phase<EpiRes, pg8::StaticOrder, true, true>((PG8_LAS unsigned char*)smem, g, S, e);
        }
        else if (ph == 4 || ph == 9) {
            const int l = ph == 4 ? 0 : 1;
            EpiScores e{(const float*)(ws + (l ? WS_SSB : WS_SSA)), (float*)(ws + WS_SCORES)};
            pg8::Gemm g{XB, (const bf16_t*)(ws + WS_WQK) + (size_t)l * 2048 * 1024, T_TOK, 2048, 1024}; pg8::StaticOrder S; S.init(T_TOK, 2048, gridDim.x, blockIdx.x);
            pg8::gemm_phase<EpiScores, pg8::StaticOrder, true, true>((PG8_LAS unsigned char*)smem, g, S, e);
            if (!(dry && PROBE_S5_MODE == 9))
                phase_topk_own((const float*)(ws + WS_SCORES), (int*)(ws + WS_IDX), (float*)(ws + WS_GATE), smem, S);
        } else if (ph == 6) {
            phase_expert6d<0>(XB, (const float*)(ws + WS_SSA), (const int*)(ws + WS_IDX), (const float*)(ws + WS_GATE), ws + WS_UTAB, ws + WS_VTAB, (const float*)(ws + WS_SU), (const float*)(ws + WS_SV),
                            p.out, p.norm_mix_g + DM, (bf16_t*)(ws + WS_BIG + MB(64)), smem, nb_, dry, dry ? PROBE_S5_MODE : 0);
        }
        else if (ph == 7) {
            phase_s5((const bf16_t*)(ws + WS_BIG + MB(64)), (const bf16_t*)(ws + WS_KTAB), (const bf16_t*)(ws + WS_ME), (const bf16_t*)(ws + WS_MY), (const float*)(ws + WS_LAM64), p.s5_d, (bf16_t*)(ws + WS_GBUF), smem, dry ? PROBE_S5_MODE : 0);
        } else if (ph == 8) {
            EpiGlu e{(const bf16_t*)(ws + WS_GBUF), p.glu_b, p.out, XB, (float*)(ws + WS_SSB), dry};
            pg8::Gemm g{(const bf16_t*)(ws + WS_GBUF), (const bf16_t*)(ws + WS_WTGLU), T_TOK, 1024, 1024}; pg8::StaticOrder S; S.init(T_TOK, 1024, gridDim.x, blockIdx.x);
            pg8::gemm_phase<EpiGlu, pg8::StaticOrder, true, true>((PG8_LAS unsigned char*)smem, g, S, e);
        } else if (ph == 11) {
            phase_expert6d<1>(XB, (const float*)(ws + WS_SSB), (const int*)(ws + WS_IDX), (const float*)(ws + WS_GATE), ws + WS_UTAB + MB(12), ws + WS_VTAB + MB(12), (const float*)(ws + WS_SU) + 16384, (const float*)(ws + WS_SV) + 16384,
                            p.out, p.final_g, XB, smem, nb_, dry, dry ? PROBE_S5_MODE : 0);
        }
        }
        if (ph < ph_hi || PROBE_REPLAY_K >= 0) { if (ph_lo < 0) grid.sync(); else xcd_barrier(xb); }
    }
#endif
}

static void fill_params(P& p, void* const* d_in, void* d_out, void* d_ws) {
    const float** f = (const float**)&p;
    for (int i = 0; i < 23; ++i) f[i] = (const float*)d_in[i];
    p.out = (float*)d_out; p.ws = (unsigned char*)d_ws;
}
#define LAST_OPT_PHASE 11
extern "C" void kernel_launch(void* const* d_in, const int* in_sizes, int n_in, void* d_out, int out_size, void* d_ws, size_t ws_size, hipStream_t stream) {
    static int grid = 0;
    if (!grid) {
        int dev = 0, cus = 0, per_cu = 0;
        (void)hipGetDevice(&dev); (void)hipDeviceGetAttribute(&cus, hipDeviceAttributeMultiprocessorCount, dev);
        (void)hipFuncSetAttribute((const void*)mega, hipFuncAttributeMaxDynamicSharedMemorySize, LDS_TOTAL);
        (void)hipOccupancyMaxActiveBlocksPerMultiprocessor(&per_cu, (const void*)mega, 512, LDS_TOTAL);
        if (per_cu < 1) { fprintf(stderr, "kernel_launch: occupancy query reports %d blocks/CU\n", per_cu); per_cu = 1; }
        grid = cus;
        if (ws_size < (size_t)WS_END) fprintf(stderr, "kernel_launch: workspace too small (%zu < %zu)\n", ws_size, (size_t)WS_END);
    }
    P p{}; fill_params(p, d_in, d_out, d_ws);
    p.ph_lo = 0; p.ph_hi = LAST_OPT_PHASE; p.rep_ph = PROBE_REP_PH; p.rep_n = PROBE_REP_N;
    (void)hipMemsetAsync((char*)d_ws + WS_BAR, 0, XCD_BAR_WORDS * sizeof(unsigned), stream);
    void* args[] = {&p};
    hipError_t e = hipLaunchCooperativeKernel((const void*)mega, dim3(grid), dim3(512), args, LDS_TOTAL, stream);
    if (e != hipSuccess) fprintf(stderr, "cooperative launch failed: %s (grid %d)\n", hipGetErrorString(e), grid);
}
```

```cpp
#include <hip/hip_runtime.h>
#include <hip/hip_cooperative_groups.h>
#include <cstdint>
#include <cstdio>
namespace cg = cooperative_groups;
#define PROBE_REP_PH -1
#define PROBE_REP_N 0
#define PROBE_S5_MODE 0
#define PROBE_REPLAY_K -1
#define XB_TMO      128
#define XB_XCNT(j)  (256  + 64 * (j))
#define XB_XSUB(j)  (1280 + 64 * (j))
#define XB_XGEN(j)  (2304 + 64 * (j))
#define XB_TOP      3328
#define XB_TOPGEN   3392
#define XCD_BAR_WORDS 3456
#define XB_SPIN_CAP (1u << 18)
#define LAS __attribute__((address_space(3)))

__device__ __forceinline__ unsigned xb_ld(unsigned* p)              { return __hip_atomic_load(p, __ATOMIC_RELAXED, __HIP_MEMORY_SCOPE_AGENT); }
__device__ __forceinline__ unsigned xb_add(unsigned* p, unsigned v) { return __hip_atomic_fetch_add(p, v, __ATOMIC_RELAXED, __HIP_MEMORY_SCOPE_AGENT); }
__device__ __forceinline__ unsigned xb_xcc_id() { return (unsigned)__builtin_amdgcn_s_getreg((3 << 11) | 20) & 0xFu; }
#define XB_SPIN(cond, bar) do { unsigned _sp = 0; while (cond) { __builtin_amdgcn_s_sleep(1); \
    if ((++_sp & 255u) == 0u) { if (xb_ld(&(bar)[XB_TMO])) break; if (_sp > XB_SPIN_CAP) { atomicAdd(&(bar)[XB_TMO], 1u); break; } } } } while (0)

struct XcdBarrier {
    unsigned* bar; unsigned x;
    volatile LAS unsigned* st;
};

__device__ __forceinline__ XcdBarrier xcd_barrier_post(unsigned* bar, volatile LAS unsigned* st) {
    XcdBarrier b; b.bar = bar; b.x = xb_xcc_id(); b.st = st;
    if (threadIdx.x == 0) (void)xb_add(&bar[XB_XCNT(b.x)], 1u);
    return b;
}
__device__ __forceinline__ void xcd_barrier_complete(unsigned* bar, unsigned x, unsigned& nloc, unsigned& nx) {
    const unsigned G = gridDim.x * gridDim.y * gridDim.z;
    unsigned sum, cnt, mine, sp = 0u;
    for (;;) {
        sum = 0u; cnt = 0u; mine = 0u;
#pragma unroll
        for (unsigned j = 0; j < 16; ++j) { const unsigned c = xb_ld(&bar[XB_XCNT(j)]); sum += c; cnt += (c > 0u) ? 1u : 0u; mine = (j == x) ? c : mine; }
        if (sum == G) break;
        __builtin_amdgcn_s_sleep(1);
        if ((++sp & 255u) == 0u) { if (xb_ld(&bar[XB_TMO])) break; if (sp > XB_SPIN_CAP) { atomicAdd(&bar[XB_TMO], 1u); break; } }
    }
    nloc = mine > 0u ? mine : 1u; nx = cnt > 0u ? cnt : 1u;
}

__device__ __forceinline__ void xcd_barrier(const XcdBarrier& b) {
    asm volatile("s_waitcnt vmcnt(0)" ::: "memory");
    __syncthreads();
    if (threadIdx.x == 0) {
        unsigned* bar = b.bar;
        __builtin_amdgcn_s_waitcnt(0);
        unsigned nloc = b.st[0], nx = b.st[1];
        if (nloc == 0u) { xcd_barrier_complete(bar, b.x, nloc, nx); b.st[0] = nloc; b.st[1] = nx; }
        const unsigned old = xb_add(&bar[XB_XSUB(b.x)], 1u);
        const unsigned gen = old / nloc;
        if (old + 1u == (gen + 1u) * nloc) {
            __builtin_amdgcn_fence(__ATOMIC_RELEASE, "agent");
            asm volatile("s_waitcnt vmcnt(0)" ::: "memory");
            const unsigned og = xb_add(&bar[XB_TOP], 1u);
            const unsigned tg = og / nx;
            if (og + 1u == (tg + 1u) * nx) xb_add(&bar[XB_TOPGEN], 1u);
            else XB_SPIN(xb_ld(&bar[XB_TOPGEN]) == tg, bar);
            __builtin_amdgcn_fence(__ATOMIC_ACQUIRE, "agent");
            xb_add(&bar[XB_XGEN(b.x)], 1u);
            asm volatile("s_waitcnt vmcnt(0)" ::: "memory");
        } else {
            XB_SPIN(xb_ld(&bar[XB_XGEN(b.x)]) == gen, bar);
            __builtin_amdgcn_fence(__ATOMIC_ACQUIRE, "agent");
            asm volatile("s_waitcnt vmcnt(0)" ::: "memory");
        }
    }
    __syncthreads();
}

namespace pg8 {
#define PG8_LAS __attribute__((address_space(3)))
typedef unsigned short bf16_t;
typedef short bf16x8 __attribute__((ext_vector_type(8)));
typedef float f32x4 __attribute__((ext_vector_type(4)));
typedef unsigned u32x4 __attribute__((ext_vector_type(4)));
constexpr int BM = 256, BK = 64, HALF = 128, HTB = HALF * BK * 2  , STAGE_BYTES = 8 * HTB, NXCD = 8, WGM = 8;

__host__ __device__ __forceinline__ int lds_byte(int r, int c) { const int st = (r >> 4) * 2 + (c >> 5), rr = r & 15, cc = c & 31, ob = rr * 64 + cc * 2; return st * 1024 + (ob ^ (((ob >> 9) & 1) << 5)); }
__host__ __device__ __forceinline__ void stage_rc(int b, int& R, int& C) { const int st = b / 1024, sb = b % 1024, swz = sb ^ (((sb >> 9) & 1) << 5); R = (st >> 1) * 16 + swz / 64; C = (st & 1) * 32 + (swz % 64) / 2; }
__host__ __device__ __forceinline__ int perm32(int rho) { const int n = rho >> 4, i = rho & 15; return 8 * (i >> 2) + 4 * n + (i & 3); }

struct Unit { int pm, pn; };
struct Gemm { const bf16_t* A; const bf16_t* Bt; int M, N, K; };

struct StaticOrder {
    int nM, nN, nwg, G, c;
    __host__ __device__ void init(int M, int N, int G_, int c_) { nM = M / BM; nN = N / BM; nwg = nM * nN; G = G_; c = c_; }
    __host__ __device__ bool next(int i, Unit& u) const {
        const long L = (long)i * G + c; if (L >= nwg) return false;
        int wgid = (int)L; { const int q = nwg / NXCD, r = nwg % NXCD, xcd = wgid % NXCD, off = wgid / NXCD; wgid = (xcd < r ? xcd * (q + 1) : r * (q + 1) + (xcd - r) * q) + off; }
        const int nig = WGM * nN, gid = wgid / nig, fm = gid * WGM, gsz = (nM - fm) < WGM ? (nM - fm) : WGM;
        u.pm = fm + ((wgid % nig) % gsz); u.pn = (wgid % nig) / gsz; return true;
    }
    __device__ __forceinline__ void a_ready(const Unit&) const {}
    __device__ __forceinline__ void done(const Unit&) const {}
};

template <class Epi, class Sched, bool ALIGN_EPI = false, bool SP2 = false>
__device__ __forceinline__ void gemm_phase(PG8_LAS unsigned char* lds, const Gemm g, const Sched& S, const Epi& E) {
    int tid_ = threadIdx.x; asm volatile("" : "+v"(tid_));
    const int tid = tid_, wid = __builtin_amdgcn_readfirstlane(tid >> 6), lane = tid & 63, wr = wid >> 2, wc = wid & 3, fr = lane & 15, fq = lane >> 4;
    const int K = g.K, nt = K / BK;
    unsigned voffA[2], voffB[2];
#pragma unroll
    for (int i = 0; i < 2; ++i) { int R, C; stage_rc(tid * 16 + i * 8192, R, C); const int Rb = Epi::PERM ? ((R & ~31) + perm32(R & 31)) : R;
        voffA[i] = (unsigned)(R * K + C) * 2u; voffB[i] = (unsigned)(Rb * K + C) * 2u; }
    const size_t kstep = (size_t)(BK * 2);
    const size_t hstep = (size_t)HALF * K * 2;
    const size_t tstep = 2 * hstep;
    const unsigned ldsw = (unsigned)wid * 1024u;
    const int aoff = lds_byte(wr * 64 + fr, fq * 8), boff = lds_byte(wc * 32 + fr, fq * 8);
#define PG8_SA(b, h) (((b) * 2 + (h)) * HTB)
#define PG8_SB(b, h) ((4 + (b) * 2 + (h)) * HTB)
#define PG8_STAGE(bufoff, gbase, voff) do { _Pragma("unroll") for (int _i = 0; _i < 2; ++_i) \
        __builtin_amdgcn_global_load_lds((const unsigned*)((const char*)(gbase) + (voff)[_i]), (PG8_LAS unsigned*)(lds + (bufoff) + ldsw + _i * 8192), 16, 0, 0); } while (0)
#define PG8_LDA(dst, b, h) do { _Pragma("unroll") for (int m = 0; m < 4; ++m) _Pragma("unroll") for (int k = 0; k < 2; ++k) dst[m][k] = *(const PG8_LAS bf16x8*)(lds + PG8_SA(b, h) + aoff + m * 2048 + k * 1024); } while (0)
#define PG8_LDB(dst, b, h) do { _Pragma("unroll") for (int n = 0; n < 2; ++n) _Pragma("unroll") for (int k = 0; k < 2; ++k) dst[n][k] = *(const PG8_LAS bf16x8*)(lds + PG8_SB(b, h) + boff + n * 2048 + k * 1024); } while (0)
#define PG8_MMA(ai, bj, At, Bt) do { __builtin_amdgcn_s_setprio(1); _Pragma("unroll") for (int m = 0; m < 4; ++m) _Pragma("unroll") for (int n = 0; n < 2; ++n) _Pragma("unroll") for (int k = 0; k < 2; ++k) \
        acc[ai][bj][m][n] = __builtin_amdgcn_mfma_f32_16x16x32_bf16(Bt[n][k], At[m][k], acc[ai][bj][m][n], 0, 0, 0); __builtin_amdgcn_s_setprio(0); } while (0)
#define PG8_WAIT_V(n) asm volatile("s_waitcnt vmcnt(" #n ")" ::: "memory")
#define PG8_WAIT_L(n) asm volatile("s_waitcnt lgkmcnt(" #n ")" ::: "memory")
#define PG8_BAR __builtin_amdgcn_s_barrier()
#define PG8_SCHED __builtin_amdgcn_sched_barrier(0)
    Unit cur, nxt; int ui = 0;
    if (!S.next(0, cur)) return;
    f32x4 acc[2][2][4][2];
#pragma unroll
    for (int a = 0; a < 2; ++a)
#pragma unroll
        for (int b = 0; b < 2; ++b)
#pragma unroll
            for (int m = 0; m < 4; ++m)
#pragma unroll
                for (int n = 0; n < 2; ++n) acc[a][b][m][n] = (f32x4){0.f, 0.f, 0.f, 0.f};
    bf16x8 At[4][2], B0[2][2], B1[2][2];
    const char* cA = (const char*)g.A + (size_t)cur.pm * tstep; const char* cB = (const char*)g.Bt + (size_t)cur.pn * tstep;
    S.a_ready(cur);
    if constexpr (SP2) {
        PG8_STAGE(PG8_SB(0, 0), cB, voffB); PG8_STAGE(PG8_SB(0, 1), cB + hstep, voffB); PG8_STAGE(PG8_SA(0, 0), cA, voffA); PG8_STAGE(PG8_SA(0, 1), cA + hstep, voffA);
        if (wr == 1) PG8_BAR;
        PG8_WAIT_V(2); PG8_BAR;
        PG8_STAGE(PG8_SB(1, 0), cB + kstep, voffB); PG8_STAGE(PG8_SA(1, 0), cA + kstep, voffA); PG8_STAGE(PG8_SB(1, 1), cB + hstep + kstep, voffB);
        PG8_WAIT_V(6); PG8_BAR;
    } else {
        PG8_STAGE(PG8_SB(0, 0), cB, voffB); PG8_STAGE(PG8_SA(0, 0), cA, voffA); PG8_STAGE(PG8_SB(0, 1), cB + hstep, voffB); PG8_STAGE(PG8_SA(0, 1), cA + hstep, voffA);
        if (wr == 1) PG8_BAR;
        PG8_WAIT_V(4); PG8_BAR;
        PG8_STAGE(PG8_SB(1, 0), cB + kstep, voffB); PG8_STAGE(PG8_SA(1, 0), cA + kstep, voffA); PG8_STAGE(PG8_SB(1, 1), cB + hstep + kstep, voffB);
        PG8_WAIT_V(6); PG8_BAR;
    }
    for (;;) {
        const bool has_next = S.next(ui + 1, nxt);
        const char* nA = has_next ? (const char*)g.A + (size_t)nxt.pm * tstep : cA; const char* nB = has_next ? (const char*)g.Bt + (size_t)nxt.pn * tstep : cB;
        for (int t = 0; t < nt; t += 2) {
            const bool last = (t == nt - 2);
            const char* a1 = cA + (size_t)(t + 1) * kstep;
            const char* a2 = last ? nA : cA + (size_t)(t + 2) * kstep; const char* b2 = last ? nB : cB + (size_t)(t + 2) * kstep;
            const char* a3 = a2 + kstep; const char* b3 = b2 + kstep;
            if (last && has_next) S.a_ready(nxt);
            if constexpr (SP2) {
            PG8_LDB(B0, 0, 0); PG8_LDB(B1, 0, 1); PG8_SCHED; PG8_LDA(At, 0, 0); PG8_STAGE(PG8_SA(1, 1), a1 + hstep, voffA);
            PG8_WAIT_V(8); PG8_WAIT_L(0); PG8_BAR; PG8_MMA(0, 0, At, B0); PG8_MMA(0, 1, At, B1); PG8_BAR; PG8_SCHED;
            PG8_LDA(At, 0, 1); PG8_STAGE(PG8_SB(0, 0), b2, voffB); PG8_STAGE(PG8_SB(0, 1), b2 + hstep, voffB); PG8_STAGE(PG8_SA(0, 0), a2, voffA);
            PG8_WAIT_V(8); PG8_WAIT_L(0); PG8_BAR; PG8_MMA(1, 0, At, B0); PG8_MMA(1, 1, At, B1); PG8_BAR; PG8_SCHED;
            PG8_LDB(B0, 1, 0); PG8_LDB(B1, 1, 1); PG8_SCHED; PG8_LDA(At, 1, 0); PG8_STAGE(PG8_SA(0, 1), a2 + hstep, voffA);
            PG8_WAIT_V(8); PG8_WAIT_L(0); PG8_BAR; PG8_MMA(0, 0, At, B0); PG8_MMA(0, 1, At, B1); PG8_BAR; PG8_SCHED;
            PG8_LDA(At, 1, 1); PG8_STAGE(PG8_SB(1, 0), b3, voffB); PG8_STAGE(PG8_SB(1, 1), b3 + hstep, voffB); PG8_STAGE(PG8_SA(1, 0), a3, voffA);
            PG8_WAIT_V(8); PG8_WAIT_L(0); PG8_BAR; PG8_MMA(1, 0, At, B0); PG8_MMA(1, 1, At, B1); PG8_BAR; PG8_SCHED;
            } else {
            PG8_LDB(B0, 0, 0); PG8_SCHED; PG8_LDA(At, 0, 0); PG8_STAGE(PG8_SA(1, 1), a1 + hstep, voffA);
            PG8_WAIT_L(8); PG8_BAR; PG8_WAIT_L(0); PG8_MMA(0, 0, At, B0); PG8_BAR; PG8_SCHED;
            PG8_LDB(B1, 0, 1); PG8_STAGE(PG8_SB(0, 0), b2, voffB);
            PG8_BAR; PG8_WAIT_L(0); PG8_MMA(0, 1, At, B1); PG8_BAR;
            PG8_LDA(At, 0, 1); PG8_STAGE(PG8_SA(0, 0), a2, voffA);
            PG8_BAR; PG8_WAIT_L(0); PG8_MMA(1, 0, At, B0); PG8_BAR; PG8_SCHED;
            PG8_STAGE(PG8_SB(0, 1), b2 + hstep, voffB);
            PG8_WAIT_V(6); PG8_BAR; PG8_MMA(1, 1, At, B1); PG8_BAR;
            PG8_LDB(B0, 1, 0); PG8_SCHED; PG8_LDA(At, 1, 0); PG8_STAGE(PG8_SA(0, 1), a2 + hstep, voffA);
            PG8_WAIT_L(8); PG8_BAR; PG8_WAIT_L(0); PG8_MMA(0, 0, At, B0); PG8_BAR; PG8_SCHED;
            PG8_LDB(B1, 1, 1); PG8_STAGE(PG8_SB(1, 0), b3, voffB);
            PG8_BAR; PG8_WAIT_L(0); PG8_MMA(0, 1, At, B1); PG8_BAR;
            PG8_LDA(At, 1, 1); PG8_STAGE(PG8_SA(1, 0), a3, voffA);
            PG8_BAR; PG8_WAIT_L(0); PG8_MMA(1, 0, At, B0); PG8_BAR; PG8_SCHED;
            PG8_STAGE(PG8_SB(1, 1), b3 + hstep, voffB);
            PG8_WAIT_V(6); PG8_BAR; PG8_MMA(1, 1, At, B1); PG8_BAR;
            }
        }
        if constexpr (ALIGN_EPI) { if (wr == 0) PG8_BAR; }
        if constexpr (!Epi::AFTER_DRAIN) { E(acc, cur, wr, wc, fr, fq); S.done(cur); }
        if (!has_next) break;
#pragma unroll
        for (int a = 0; a < 2; ++a)
#pragma unroll
            for (int b = 0; b < 2; ++b)
#pragma unroll
                for (int m = 0; m < 4; ++m)
#pragma unroll
                    for (int n = 0; n < 2; ++n) acc[a][b][m][n] = (f32x4){0.f, 0.f, 0.f, 0.f};
        cur = nxt; cA = nA; cB = nB; ++ui;
        if constexpr (ALIGN_EPI) { if (wr == 1) PG8_BAR; }
    }
    PG8_WAIT_V(0);
    if constexpr (!ALIGN_EPI) { if (wr == 0) PG8_BAR; }
    PG8_BAR;
    if constexpr (Epi::AFTER_DRAIN) { E.fused(acc, cur, wr, wc, fr, fq, lds, wid, lane); S.done(cur); }
#undef PG8_SA
#undef PG8_SB
#undef PG8_STAGE
#undef PG8_LDA
#undef PG8_LDB
#undef PG8_MMA
#undef PG8_WAIT_V
#undef PG8_WAIT_L
#undef PG8_BAR
#undef PG8_SCHED
}
}
typedef unsigned short bf16_t;
typedef short bf16x8 __attribute__((ext_vector_type(8)));
typedef float f32x4 __attribute__((ext_vector_type(4)));
typedef float f32x16 __attribute__((ext_vector_type(16)));
typedef unsigned u32x4 __attribute__((ext_vector_type(4)));
typedef unsigned u32x2 __attribute__((ext_vector_type(2)));
typedef __bf16 bf16x2v __attribute__((ext_vector_type(2)));

#define T_TOK 32768
#define SEQ 2048
#define DM 1024
#define MB(x) ((size_t)(x) << 20)

struct P {
    const float *x, *norm_mix_g, *norm_ffn_g, *final_g, *w_in, *sgu_norm_g, *sgu_w, *sgu_b, *w_out, *lam_re, *lam_im, *b_re, *b_im, *c_re, *c_im,
        *s5_d, *log_step, *glu_w, *glu_b, *wq, *subkeys, *pu, *pv;
    float* out;
    unsigned char* ws;
    int ph_lo, ph_hi, rep_ph, rep_n;
};
#define WS_XB MB(0)
#define WS_BIG MB(64)
#define WS_Q (WS_BIG)
#define WS_K (WS_BIG + MB(32))
#define WS_VT (WS_BIG + MB(64))
#define WS_UG (WS_BIG + MB(96))
#define WS_GG (WS_BIG + MB(128))
#define WS_MIXB (WS_BIG + MB(160))
#define WS_SCORES (WS_BIG)
#define WS_GBUF (WS_BIG)
#define WS_UTAB MB(320)
#define WS_VTAB MB(352)
#define WS_IDX MB(384)
#define WS_GATE MB(400)
#define WS_WTIN MB(416)
#define WS_WTOUT MB(421)
#define WS_WTGLU MB(423)
#define WS_WQK MB(425)
#define WS_KTAB MB(433)
#define WS_ME MB(436)
#define WS_MY MB(452)
#define WS_SSA MB(468)
#define WS_SSB (MB(468) + (128 << 10))
#define WS_LAM64 (MB(468) + (256 << 10))
#define WS_SU (MB(468) + (320 << 10))
#define WS_SV (MB(468) + (448 << 10))
#define WS_BAR (MB(468) + (576 << 10))
#define WS_END MB(469)

__device__ __forceinline__ unsigned cvt_pk_bf16(float lo, float hi) { unsigned r; asm volatile("v_cvt_pk_bf16_f32 %0, %1, %2" : "=v"(r) : "v"(lo), "v"(hi)); return r; }
__device__ __forceinline__ float bf_lo(unsigned u) { return __uint_as_float(u << 16); }
__device__ __forceinline__ float bf_hi(unsigned u) { return __uint_as_float(u & 0xffff0000u); }
__device__ __forceinline__ float gelu_t(float x) {
    const float u = 1.5957691216057308f * (x + 0.044715f * x * x * x);
    return x * __builtin_amdgcn_rcpf(1.0f + __expf(-u));
}
__device__ __forceinline__ float wave_sum(float v) {
#pragma unroll
    for (int o = 32; o > 0; o >>= 1) v += __shfl_xor(v, o);
    return v;
}
__device__ __forceinline__ bf16x8 pack8(float a0, float a1, float a2, float a3, float a4, float a5, float a6, float a7) {
    u32x4 r; r.x = cvt_pk_bf16(a0, a1); r.y = cvt_pk_bf16(a2, a3); r.z = cvt_pk_bf16(a4, a5); r.w = cvt_pk_bf16(a6, a7);
    return __builtin_bit_cast(bf16x8, r);
}
#define MFMA16(a, b, c) __builtin_amdgcn_mfma_f32_16x16x32_bf16((a), (b), (c), 0, 0, 0)
#define MFMA32(a, b, c) __builtin_amdgcn_mfma_f32_32x32x16_bf16((a), (b), (c), 0, 0, 0)

typedef f32x4 acc_t[2][2][4][2];

struct EpiIn {
    bf16_t *Q, *K, *VT, *UG, *GG;
    static constexpr bool PERM = false, AFTER_DRAIN = false;
    __device__ __forceinline__ void operator()(const acc_t& acc, const pg8::Unit& u, int wr, int wc, int fr_, int fq_) const {
        const int pm = u.pm, pn = u.pn; int fr = fr_, fq = fq_; asm volatile("" : "+v"(fr), "+v"(fq));
        const int region = pn >> 1, hg = (pn & 1) * 4 + wc;
        if (region <= 1) {
            bf16_t* base = region == 0 ? Q : K; const float sc = region == 0 ? 0.125f * 1.4426950408889634f : 1.0f;
            float invrev[2][4];
#pragma unroll
            for (int n = 0; n < 2; ++n)
#pragma unroll
                for (int j = 0; j < 4; ++j) invrev[n][j] = exp2f(-(float)(n * 16 + fq * 4 + j) * (13.287712379549449f / 32.0f)) * 0.15915494309189535f;
#pragma unroll
            for (int ai = 0; ai < 2; ++ai)
#pragma unroll
                for (int m = 0; m < 4; ++m) {
                    const int t = pm * 256 + ai * 128 + wr * 64 + m * 16 + fr, b = t >> 11, pos = t & 2047;
                    bf16_t* rowp = base + ((size_t)(b * 8 + hg) * SEQ + pos) * 64;
#pragma unroll
                    for (int n = 0; n < 2; ++n) {
                        float o1[4], o2[4];
#pragma unroll
                        for (int j = 0; j < 4; ++j) {
                            const float rev = __builtin_amdgcn_fractf((float)pos * invrev[n][j]);
                            const float sn = __builtin_amdgcn_sinf(rev), cs = __builtin_amdgcn_cosf(rev);
                            const float x1 = acc[ai][0][m][n][j], x2 = acc[ai][1][m][n][j];
                            o1[j] = (x1 * cs - x2 * sn) * sc; o2[j] = (x2 * cs + x1 * sn) * sc;
                        }
                        u32x2 w1, w2; w1.x = cvt_pk_bf16(o1[0], o1[1]); w1.y = cvt_pk_bf16(o1[2], o1[3]); w2.x = cvt_pk_bf16(o2[0], o2[1]); w2.y = cvt_pk_bf16(o2[2], o2[3]);
                        *(u32x2*)(rowp + n * 16 + fq * 4) = w1; *(u32x2*)(rowp + 32 + n * 16 + fq * 4) = w2;
                    }
                    __builtin_amdgcn_sched_barrier(0);
                }
        } else if (region == 2) {
#pragma unroll
            for (int ai = 0; ai < 2; ++ai) {
                const int t0 = pm * 256 + ai * 128 + wr * 64, b = t0 >> 11, i0 = (t0 & 2047) >> 4;
                bf16_t* vb = VT + (size_t)(b * 8 + hg) * 64 * SEQ + fr * 128 + i0;
#pragma unroll
                for (int bj = 0; bj < 2; ++bj)
#pragma unroll
                    for (int n = 0; n < 2; ++n)
#pragma unroll
                        for (int j = 0; j < 4; ++j) {
                            const int d = bj * 32 + n * 16 + fq * 4 + j;
                            u32x2 w; w.x = cvt_pk_bf16(acc[ai][bj][0][n][j], acc[ai][bj][1][n][j]); w.y = cvt_pk_bf16(acc[ai][bj][2][n][j], acc[ai][bj][3][n][j]);
                            *(u32x2*)(vb + (size_t)d * SEQ) = w;
                        }
                __builtin_amdgcn_sched_barrier(0);
            }
        } else {
            bf16_t* base = region == 3 ? UG : GG;
#pragma unroll
            for (int ai = 0; ai < 2; ++ai)
#pragma unroll
                for (int m = 0; m < 4; ++m) {
                    const int t = pm * 256 + ai * 128 + wr * 64 + m * 16 + fr;
                    bf16_t* rowp = base + (size_t)t * 512 + hg * 64;
#pragma unroll
                    for (int bj = 0; bj < 2; ++bj)
#pragma unroll
                        for (int n = 0; n < 2; ++n) {
                            const f32x4 v = acc[ai][bj][m][n];
                            u32x2 w; w.x = cvt_pk_bf16(gelu_t(v[0]), gelu_t(v[1])); w.y = cvt_pk_bf16(gelu_t(v[2]), gelu_t(v[3]));
                            *(u32x2*)(rowp + bj * 32 + n * 16 + fq * 4) = w;
                        }
                    __builtin_amdgcn_sched_barrier(0);
                }
        }
    }
};

struct EpiRes {
    const float* xin; float* xout; bf16_t* XB; float* sumsq; bool dry;
    static constexpr bool PERM = false, AFTER_DRAIN = false;
    __device__ __forceinline__ void operator()(const acc_t& acc, const pg8::Unit& u, int wr, int wc, int fr_, int fq_) const {
        const int pm = u.pm, pn = u.pn; int fr = fr_, fq = fq_; asm volatile("" : "+v"(fr), "+v"(fq));
        float ssq_[2][4];
#pragma unroll
        for (int ai = 0; ai < 2; ++ai) {
            f32x4 xv[4][2][2];
#pragma unroll
            for (int m = 0; m < 4; ++m)
#pragma unroll
                for (int bj = 0; bj < 2; ++bj)
#pragma unroll
                    for (int n = 0; n < 2; ++n) xv[m][bj][n] = *(const f32x4*)(xin + (size_t)(pm * 256 + ai * 128 + wr * 64 + m * 16 + fr) * DM + pn * 256 + bj * 128 + wc * 32 + n * 16 + fq * 4);
#pragma unroll
            for (int m = 0; m < 4; ++m) {
                const int t = pm * 256 + ai * 128 + wr * 64 + m * 16 + fr; float ss = 0.f;
#pragma unroll
                for (int bj = 0; bj < 2; ++bj)
#pragma unroll
                    for (int n = 0; n < 2; ++n) {
                        const size_t off = (size_t)t * DM + pn * 256 + bj * 128 + wc * 32 + n * 16 + fq * 4;
                        const f32x4 v = xv[m][bj][n] + acc[ai][bj][m][n];
                        u32x2 w; w.x = cvt_pk_bf16(v[0], v[1]); w.y = cvt_pk_bf16(v[2], v[3]);
                        if (!dry) *(u32x2*)(XB + off) = w;
                        ss += (v[0] * v[0] + v[1] * v[1]) + (v[2] * v[2] + v[3] * v[3]);
                    }
                ss += __shfl_xor(ss, 16); ss += __shfl_xor(ss, 32);
                ssq_[ai][m] = ss;
            }
            __builtin_amdgcn_sched_barrier(0);
        }
        if (fq == 0 && !dry) {
#pragma unroll
            for (int ai = 0; ai < 2; ++ai)
#pragma unroll
                for (int m = 0; m < 4; ++m) atomicAdd(sumsq + pm * 256 + ai * 128 + wr * 64 + m * 16 + fr, ssq_[ai][m]);
        }
    }
};
__device__ __forceinline__ void pro_rmsnorm_rows(const float* __restrict__ x, const float* __restrict__ g, bf16_t* __restrict__ XB, int gw, int nw, int lane) {
    for (int t0 = gw * 2; t0 < T_TOK; t0 += nw * 2) {
        f32x4 v[2][4]; float ss[2];
#pragma unroll
        for (int u = 0; u < 2; ++u) { const float* xr = x + (size_t)(t0 + u) * DM + lane * 16;
#pragma unroll
            for (int i = 0; i < 4; ++i) v[u][i] = *(const f32x4*)(xr + 4 * i); }
#pragma unroll
        for (int u = 0; u < 2; ++u) { ss[u] = 0.f;
#pragma unroll
            for (int i = 0; i < 4; ++i) ss[u] += (v[u][i][0] * v[u][i][0] + v[u][i][1] * v[u][i][1]) + (v[u][i][2] * v[u][i][2] + v[u][i][3] * v[u][i][3]); }
#pragma unroll
        for (int o = 32; o > 0; o >>= 1) { ss[0] += __shfl_xor(ss[0], o); ss[1] += __shfl_xor(ss[1], o); }
#pragma unroll
        for (int u = 0; u < 2; ++u) {
            const float rs = rsqrtf(ss[u] * (1.0f / DM) + 1e-6f);
            u32x4 o[2];
#pragma unroll
            for (int i = 0; i < 4; ++i) { const f32x4 gv = *(const f32x4*)(g + lane * 16 + 4 * i); const f32x4 r = v[u][i] * gv * rs;
                const unsigned a = cvt_pk_bf16(r[0], r[1]), b = cvt_pk_bf16(r[2], r[3]);
                if ((i & 1) == 0) { o[i >> 1].x = a; o[i >> 1].y = b; } else { o[i >> 1].z = a; o[i >> 1].w = b; } }
            *(u32x4*)(XB + (size_t)(t0 + u) * DM + lane * 16) = o[0]; *(u32x4*)(XB + (size_t)(t0 + u) * DM + lane * 16 + 8) = o[1];
        }
    }
}
template <bool PERM>
__device__ __forceinline__ void pro_transpose(const float* __restrict__ W, int N, const float* __restrict__ g, bf16_t* __restrict__ Wt, int gtid, int nthr) {
    const int items = N * 128;
    for (int it = gtid; it < items; it += nthr) {
        const int n = it % N, k0 = (it / N) * 8; float v[8];
#pragma unroll
        for (int i = 0; i < 8; ++i) v[i] = W[(size_t)(k0 + i) * N + n] * (g ? g[k0 + i] : 1.0f);
        int np = n;
        if (PERM) { const int tl = n >> 8, l = n & 255, wc = l >> 6, bj = (l >> 5) & 1, r32 = l & 31; np = tl * 256 + bj * 128 + wc * 32 + r32; }
        *(bf16x8*)(Wt + (size_t)np * 1024 + k0) = pack8(v[0], v[1], v[2], v[3], v[4], v[5], v[6], v[7]);
    }
}

__device__ __forceinline__ float vmax_raw(float a, float b) { float r; asm("v_max_f32 %0, %1, %2" : "=v"(r) : "v"(a), "v"(b)); return r; }
__device__ __forceinline__ void attn_range4(int cls, int r4, int tb0, int& i0, int& i_hi) {
    const bool special = ((cls ^ r4) & 3) == 0;
    int lo_s = special ? 0 : tb0 - 128; if (lo_s < 0) lo_s = 0;
    int i_lo = (lo_s - cls + 15) >> 4; if (i_lo < 0) i_lo = 0;
    i_hi = (tb0 + 12 + 240 - cls) >> 4; i0 = i_lo & ~7;
}
__device__ __forceinline__ void phase_attn(const bf16_t* __restrict__ Q, const bf16_t* __restrict__ Kp, const bf16_t* __restrict__ VT, bf16_t* __restrict__ MIXB, int gw, int nw, int lane, int abl = 0) {
    const int x = lane & 15, g = lane >> 4;
    for (int job_ = gw; job_ < 4096; job_ += nw) {
        const int job = __builtin_amdgcn_readfirstlane(job_);
        const int bh = job >> 5, rem = job & 31, r4 = rem & 3;
        const int jblk = (job >= 2048) ? 7 - (rem >> 2) : (rem >> 2);
        const int tb0 = jblk * 256 + r4;
        bf16x8 q0[4], q1[4]; f32x4 o[4][4]; float l[4];
        f32x4 negm[4]; float thr[4];
#pragma unroll
        for (int u = 0; u < 4; ++u) {
            const bf16_t* Qp = Q + ((size_t)bh * SEQ + tb0 + 4 * u + 16 * x) * 64 + 8 * g;
            q0[u] = *(const bf16x8*)Qp; q1[u] = *(const bf16x8*)(Qp + 32); l[u] = 0.f; negm[u] = (f32x4){0.f, 0.f, 0.f, 0.f}; thr[u] = -3.0e38f;
#pragma unroll
            for (int n = 0; n < 4; ++n) o[u][n] = (f32x4){0.f, 0.f, 0.f, 0.f};
        }
        const bf16_t* Kb = Kp + (size_t)bh * SEQ * 64 + 8 * g;
        const bf16_t* Vb = VT + (size_t)bh * 64 * SEQ + (size_t)x * SEQ;
        const int xo = 8 * (x >> 2) + (x & 3);
        int cls = 0, ib, i_hi; attn_range4(0, r4, tb0, ib, i_hi);
        bf16x8 kc[4], vc[4];
#define ATTN_LOADK(KD, CLS, IB) do { const int _iA = (IB) + xo, _iB = _iA + 4; const int _iAc = _iA < 127 ? _iA : 127, _iBc = _iB < 127 ? _iB : 127; \
            const bf16_t* _ka = Kb + (size_t)((CLS) + 16 * _iAc) * 64; const bf16_t* _kb = Kb + (size_t)((CLS) + 16 * _iBc) * 64; \
            KD[0] = *(const bf16x8*)_ka; KD[1] = *(const bf16x8*)(_ka + 32); KD[2] = *(const bf16x8*)_kb; KD[3] = *(const bf16x8*)(_kb + 32); } while (0)
#define ATTN_LOADV(VD, CLS, IB) do { int _iv = (IB) + 8 * g; if (_iv > 120) _iv = 120; \
            _Pragma("unroll") for (int n = 0; n < 4; ++n) VD[n] = *(const bf16x8*)(Vb + (size_t)(16 * n) * SEQ + (CLS) * 128 + _iv); } while (0)
        ATTN_LOADK(kc, cls, ib);
        bool more = true;
        bf16x8 kd[4];
#define ATTN_BODY(KC, KN, VC, VN) do { \
            if (!(abl & 1)) ATTN_LOADV(VC, cls, ib); \
            int ncls = cls, nib = ib + 32, nhi = i_hi; \
            if (nib > i_hi) { ncls = cls + 1; if (ncls < 16) attn_range4(ncls, r4, tb0, nib, nhi); } \
            more = ncls < 16; \
            { const int lc = more ? ncls : cls, li = more ? nib : ib; if (!(abl & 1)) ATTN_LOADK(KN, lc, li); else { KN[0] = KC[0]; KN[1] = KC[1]; KN[2] = KC[2]; KN[3] = KC[3]; } } \
            const bool special = ((cls ^ r4) & 3) == 0; const int ustar = (cls - r4) >> 2; \
            const int dbase = tb0 + 16 * x - cls - 16 * (ib + 8 * g); \
            _Pragma("unroll") \
            for (int u = 0; u < 4; ++u) { \
                const bool far = (tb0 + 4 * u - cls - 16 * (ib + 31)) > 512;           \
                if (special && u != ustar && far) continue;                            \
                f32x4 sA = MFMA16(KC[0], q0[u], negm[u]); sA = MFMA16(KC[1], q1[u], sA); \
                f32x4 sB = MFMA16(KC[2], q0[u], negm[u]); sB = MFMA16(KC[3], q1[u], sB); \
                float sc[8]; float mt = -INFINITY; \
                if (special) { \
                      \
                    if (u == ustar && far) {                                           \
            _Pragma("unroll") \
                        for (int jj = 0; jj < 8; ++jj) { sc[jj] = (jj < 4 ? sA[jj & 3] : sB[jj & 3]); mt = fmaxf(mt, sc[jj]); } \
                    } else if (u == ustar) {         \
            _Pragma("unroll") \
                        for (int jj = 0; jj < 8; ++jj) { \
                            const int delta = dbase + 4 * u - 16 * jj; \
                            float bias = (unsigned)delta <= 128u ? 1.584962500721156f : 1.0f; bias = (unsigned)delta <= 512u ? bias : 0.0f; \
                            const float s = (jj < 4 ? sA[jj & 3] : sB[jj & 3]) + bias; \
                            sc[jj] = delta >= 0 ? s : -INFINITY; mt = fmaxf(mt, sc[jj]); \
                        } \
                    } else {                  \
            _Pragma("unroll") \
                        for (int jj = 0; jj < 8; ++jj) { \
                            const unsigned delta = (unsigned)(dbase + 4 * u - 16 * jj); \
                            float bias = delta <= 128u ? 1.0f : 0.0f; bias = delta <= 512u ? bias : -INFINITY; \
                            sc[jj] = (jj < 4 ? sA[jj & 3] : sB[jj & 3]) + bias; mt = fmaxf(mt, sc[jj]); \
                        } \
                    } \
                } else { \
            _Pragma("unroll") \
                    for (int jj = 0; jj < 8; ++jj) { \
                        const unsigned delta = (unsigned)(dbase + 4 * u - 16 * jj); \
                        sc[jj] = delta <= 128u ? (jj < 4 ? sA[jj & 3] : sB[jj & 3]) : -INFINITY; mt = fmaxf(mt, sc[jj]); \
                    } \
                } \
                  \
                  \
                if (__builtin_amdgcn_ballot_w64(mt > thr[u]) != 0ull) { \
                    float d = mt; \
                    { const auto s16 = __builtin_amdgcn_permlane16_swap(__float_as_uint(d), __float_as_uint(d), false, false); d = vmax_raw(__uint_as_float(s16[0]), __uint_as_float(s16[1])); \
                      const auto s32 = __builtin_amdgcn_permlane32_swap(__float_as_uint(d), __float_as_uint(d), false, false); d = vmax_raw(__uint_as_float(s32[0]), __uint_as_float(s32[1])); } \
                    const bool adj = d > thr[u]; const float dd = adj ? d : 0.f; \
                    const float alpha = (adj && thr[u] > 0.f) ? __builtin_amdgcn_exp2f(-dd) : 1.0f;        \
                    l[u] *= alpha; \
            _Pragma("unroll") \
                    for (int n = 0; n < 4; ++n) o[u][n] = o[u][n] * alpha; \
                    negm[u] = negm[u] - dd; \
            _Pragma("unroll") \
                    for (int jj = 0; jj < 8; ++jj) sc[jj] -= dd; \
                    thr[u] = adj ? 8.0f : thr[u]; \
                } \
                float pj[8], ps = 0.f; \
            _Pragma("unroll") \
                for (int jj = 0; jj < 8; ++jj) { pj[jj] = __builtin_amdgcn_exp2f(sc[jj]); ps += pj[jj]; } \
                l[u] += ps; \
                const bf16x8 pf = pack8(pj[0], pj[1], pj[2], pj[3], pj[4], pj[5], pj[6], pj[7]); \
            _Pragma("unroll") \
                for (int n = 0; n < 4; ++n) o[u][n] = MFMA16(VC[n], pf, o[u][n]); \
            } \
            cls = ncls; ib = nib; i_hi = nhi; } while (0)
#pragma unroll 1
        while (more) {
            ATTN_BODY(kc, kd, vc, vc);
            if (!more) break;
            ATTN_BODY(kd, kc, vc, vc);
        }
#undef ATTN_BODY
#undef ATTN_LOADK
#undef ATTN_LOADV
        const int b = bh >> 3, h = bh & 7;
        if (abl) continue;
#pragma unroll
        for (int u = 0; u < 4; ++u) {
            float lt = l[u]; lt += __shfl_xor(lt, 16); lt += __shfl_xor(lt, 32);
            const float inv = 1.0f / lt;
            bf16_t* op = MIXB + (size_t)(b * SEQ + tb0 + 4 * u + 16 * x) * DM + h * 64 + 4 * g;
#pragma unroll
            for (int n = 0; n < 4; ++n) { u32x2 w; w.x = cvt_pk_bf16(o[u][n][0] * inv, o[u][n][1] * inv); w.y = cvt_pk_bf16(o[u][n][2] * inv, o[u][n][3] * inv); *(u32x2*)(op + 16 * n) = w; }
        }
    }
}

__device__ __forceinline__ void phase_sgu(const bf16_t* __restrict__ UG, const bf16_t* __restrict__ GG, const float* __restrict__ sgn, const float* __restrict__ sgw,
                                          const float* __restrict__ sgb, bf16_t* __restrict__ MIXB, unsigned char* smem) {
    bf16_t* GT = (bf16_t*)smem;
    int tid_ = threadIdx.x; asm volatile("" : "+v"(tid_));
    const int tid = tid_, lane = tid & 63, w = tid >> 6, x = lane & 15, g = lane >> 4;
    u32x4 graw[2];
#define SGU_LOADG(R, ITEM) do { const int _h = (ITEM) & 7, _t0 = ((ITEM) >> 3) * 128; _Pragma("unroll") for (int pass = 0; pass < 2; ++pass) \
        R[pass] = *(const u32x4*)(GG + (size_t)(_t0 + pass * 64 + (tid >> 3)) * 512 + _h * 64 + (tid & 7) * 8); } while (0)
    if ((int)blockIdx.x < 2048) SGU_LOADG(graw, (int)blockIdx.x);
    for (int item = blockIdx.x; item < 2048; item += gridDim.x) {
        const int h = item & 7, t0 = (item >> 3) * 128;
        const int i = 16 * w + x, ksmax = (16 * w + 15) >> 5;
        f32x4 wreg[4][2];
#pragma unroll
        for (int ks = 0; ks < 4; ++ks) if (ks <= ksmax) { const float* wp = sgw + (size_t)(h * 128 + i) * 128 + 32 * ks + 8 * g; wreg[ks][0] = *(const f32x4*)wp; wreg[ks][1] = *(const f32x4*)(wp + 4); }
        __syncthreads();
#pragma unroll
        for (int pass = 0; pass < 2; ++pass) {
            const int j = pass * 64 + (tid >> 3), part = tid & 7;
            const u32x4 raw = graw[pass];
            float v[8] = {bf_lo(raw.x), bf_hi(raw.x), bf_lo(raw.y), bf_hi(raw.y), bf_lo(raw.z), bf_hi(raw.z), bf_lo(raw.w), bf_hi(raw.w)};
            float s = 0.f;
#pragma unroll
            for (int e = 0; e < 8; ++e) s += v[e];
            s += __shfl_xor(s, 1); s += __shfl_xor(s, 2); s += __shfl_xor(s, 4);
            const float mu = s * (1.0f / 64.0f); float q = 0.f;
#pragma unroll
            for (int e = 0; e < 8; ++e) { v[e] -= mu; q += v[e] * v[e]; }
            q += __shfl_xor(q, 1); q += __shfl_xor(q, 2); q += __shfl_xor(q, 4);
            const float rs = rsqrtf(q * (1.0f / 64.0f) + 1e-5f);
            const f32x4 sg0 = *(const f32x4*)(sgn + h * 64 + part * 8), sg1 = *(const f32x4*)(sgn + h * 64 + part * 8 + 4);
#pragma unroll
            for (int e = 0; e < 8; ++e) GT[(part * 8 + e) * 136 + j] = (bf16_t)(cvt_pk_bf16(v[e] * rs * (e < 4 ? sg0[e & 3] : sg1[e & 3]), 0.f) & 0xffffu);
        }
        { const int nitem = item + (int)gridDim.x; if (nitem < 2048) SGU_LOADG(graw, nitem); }
        __syncthreads();
        f32x4 acc[4];
#pragma unroll
        for (int n = 0; n < 4; ++n) acc[n] = (f32x4){0.f, 0.f, 0.f, 0.f};
        const float bi = sgb[h * 128 + i]; const size_t t = (size_t)t0 + i;
        u32x2 urow[4];
#pragma unroll
        for (int n = 0; n < 4; ++n) urow[n] = *(const u32x2*)(UG + t * 512 + h * 64 + 16 * n + 4 * g);
#pragma unroll
        for (int ks = 0; ks < 4; ++ks) { if (ks > ksmax) break;
            const f32x4 w0 = wreg[ks][0], w1 = wreg[ks][1];
            const int jb = 32 * ks + 8 * g;
            const bf16x8 wf = pack8(jb + 0 <= i ? w0[0] : 0.f, jb + 1 <= i ? w0[1] : 0.f, jb + 2 <= i ? w0[2] : 0.f, jb + 3 <= i ? w0[3] : 0.f,
                                    jb + 4 <= i ? w1[0] : 0.f, jb + 5 <= i ? w1[1] : 0.f, jb + 6 <= i ? w1[2] : 0.f, jb + 7 <= i ? w1[3] : 0.f);
#pragma unroll
            for (int n = 0; n < 4; ++n) { const bf16x8 af = *(const bf16x8*)(GT + (16 * n + x) * 136 + 32 * ks + 8 * g); acc[n] = MFMA16(af, wf, acc[n]); }
        }
#pragma unroll
        for (int n = 0; n < 4; ++n) {
            const u32x2 ur = urow[n];
            u32x2 o; o.x = cvt_pk_bf16(bf_lo(ur.x) * (acc[n][0] + bi), bf_hi(ur.x) * (acc[n][1] + bi)); o.y = cvt_pk_bf16(bf_lo(ur.y) * (acc[n][2] + bi), bf_hi(ur.y) * (acc[n][3] + bi));
            *(u32x2*)(MIXB + t * DM + 512 + h * 64 + 16 * n + 4 * g) = o;
        }
    }
#undef SGU_LOADG
}
__device__ __forceinline__ void pro_wqk(const float* __restrict__ wq, const float* __restrict__ sk, const float* __restrict__ gffn, bf16_t* __restrict__ Wqk, int gw, int nw, int lane) {
    const int r = lane & 31, half = lane >> 5;
    for (int tile = gw; tile < 4096; tile += nw) {
        const int kblk = tile & 31, kb = (tile >> 5) & 3, hp = (tile >> 7) & 15, l = tile >> 11, p = hp & 1;
        const float* ap = sk + ((size_t)((l * 2 + p) * 128 + kb * 32 + r)) * 128 + 64 * half;
        const float* bp = wq + ((size_t)l * 1024 + kblk * 32 + r) * 2048 + hp * 128 + 64 * half;
        f32x16 acc;
#pragma unroll
        for (int i = 0; i < 16; ++i) acc[i] = 0.f;
        f32x4 a[4][4], b[4][4];
#pragma unroll
        for (int ch = 0; ch < 4; ++ch)
#pragma unroll
            for (int i = 0; i < 4; ++i) { a[ch][i] = *(const f32x4*)(ap + ch * 16 + 4 * i); b[ch][i] = *(const f32x4*)(bp + ch * 16 + 4 * i); }
#pragma unroll
        for (int ch = 0; ch < 4; ++ch)
#pragma unroll
            for (int i = 0; i < 4; ++i)
#pragma unroll
                for (int j = 0; j < 4; ++j) acc = __builtin_amdgcn_mfma_f32_32x32x2f32(a[ch][i][j], b[ch][i][j], acc, 0, 0, 0);
        __builtin_amdgcn_sched_group_barrier(0x020, 32, 0);
        __builtin_amdgcn_sched_group_barrier(0x008, 64, 0);
        const float gk = gffn[l * 1024 + kblk * 32 + r];
        bf16_t* op = Wqk + ((size_t)l * 2048 + hp * 128 + kb * 32) * 1024 + kblk * 32 + r;
#pragma unroll
        for (int i = 0; i < 16; ++i) { const int row = (i & 3) + 8 * (i >> 2) + 4 * half; op[(size_t)row * 1024] = (bf16_t)(cvt_pk_bf16(acc[i] * gk, 0.f) & 0xffffu); }
    }
}
__device__ __forceinline__ void pro_tables(const float* __restrict__ pu, const float* __restrict__ pv, const float* __restrict__ g, bf16_t* __restrict__ Ut, bf16_t* __restrict__ Vt, int gtid, int nthr) {
    const int items = 16384 * 128;
    for (int it = gtid; it < items; it += nthr) {
        const size_t off = (size_t)it * 8; const int d = (it & 127) * 8;
        const f32x4 a0 = *(const f32x4*)(pu + off), a1 = *(const f32x4*)(pu + off + 4), g0 = *(const f32x4*)(g + d), g1 = *(const f32x4*)(g + d + 4);
        *(bf16x8*)(Ut + off) = pack8(a0[0] * g0[0], a0[1] * g0[1], a0[2] * g0[2], a0[3] * g0[3], a1[0] * g1[0], a1[1] * g1[1], a1[2] * g1[2], a1[3] * g1[3]);
        const f32x4 b0 = *(const f32x4*)(pv + off), b1 = *(const f32x4*)(pv + off + 4);
        *(bf16x8*)(Vt + off) = pack8(b0[0], b0[1], b0[2], b0[3], b1[0], b1[1], b1[2], b1[3]);
    }
}

typedef _Float16 f16x2v __attribute__((ext_vector_type(2)));
typedef short s16x2v __attribute__((ext_vector_type(2)));
__device__ __forceinline__ unsigned pk_f16(float a, float b) { const f16x2v h = {(_Float16)a, (_Float16)b}; const s16x2v v = __builtin_bit_cast(s16x2v, h);
    const s16x2v m = (v >> (s16x2v){15, 15}) | (s16x2v){(short)0x8000, (short)0x8000}; return __builtin_bit_cast(unsigned, (s16x2v)(v ^ m)); }
struct EpiScores {
    const float* sumsq; unsigned short* ST;
    static constexpr bool PERM = false, AFTER_DRAIN = false;
    __device__ __forceinline__ void operator()(const acc_t& acc, const pg8::Unit& u, int wr, int wc, int fr_, int fq_) const {
        const int pm = u.pm, pn = u.pn; int fr = fr_, fq = fq_; asm volatile("" : "+v"(fr), "+v"(fq));
#pragma unroll
        for (int ai = 0; ai < 2; ++ai)
#pragma unroll
            for (int m = 0; m < 4; ++m) {
                const int t = pm * 256 + ai * 128 + wr * 64 + m * 16 + fr;
                unsigned short* base = ST + (((size_t)(t >> 6) * 512 + pn * 64 + wc * 8 + fq) * 64 + (t & 63)) * 4;
#pragma unroll
                for (int bj = 0; bj < 2; ++bj)
#pragma unroll
                    for (int n = 0; n < 2; ++n) { const f32x4 v = acc[ai][bj][m][n]; u32x2 w; w.x = pk_f16(v[0], v[1]); w.y = pk_f16(v[2], v[3]); *(u32x2*)(base + (size_t)(bj * 32 + n * 4) * 256) = w; }
                __builtin_amdgcn_sched_barrier(0);
            }
    }
};

__device__ __forceinline__ unsigned ord_key(float f) { const unsigned u = __float_as_uint(f); return u ^ ((unsigned)((int)u >> 31) | 0x80000000u); }
__device__ __forceinline__ float ord_val(unsigned k) { const unsigned u = (k & 0x80000000u) ? (k & 0x7fffffffu) : ~k; return __uint_as_float(u); }
__device__ __forceinline__ unsigned ord_key_u(unsigned w) { return w ^ ((unsigned)((int)w >> 31) | 0x80000000u); }
__device__ __forceinline__ float ord_val16(unsigned k) { const unsigned kk = k & 0xffff0000u; const unsigned u = (kk & 0x80000000u) ? (kk & 0x7fffffffu) : ~kk; return (float)__builtin_bit_cast(_Float16, (unsigned short)(u >> 16)); }
#define INS16(A, KEY) do { unsigned _k = (KEY); _Pragma("unroll") for (int _s = 0; _s < 16; ++_s) { const unsigned _hi = max(A[_s], _k); _k = min(A[_s], _k); A[_s] = _hi; } } while (0)


#define TK_CE(A, I, J) do { const unsigned _h = max(A[I], A[J]), _l = min(A[I], A[J]); A[I] = _h; A[J] = _l; } while (0)
__device__ __forceinline__ void tk_sort16(unsigned (&v)[16]) {
#define TK_L(...) do { const int _p[] = {__VA_ARGS__}; _Pragma("unroll") for (int _i = 0; _i < (int)(sizeof(_p) / sizeof(int)); _i += 2) TK_CE(v, _p[_i], _p[_i + 1]); } while (0)
    TK_CE(v, 0, 13); TK_CE(v, 1, 12); TK_CE(v, 2, 15); TK_CE(v, 3, 14); TK_CE(v, 4, 8); TK_CE(v, 5, 6); TK_CE(v, 7, 11); TK_CE(v, 9, 10);
    TK_CE(v, 0, 5); TK_CE(v, 1, 7); TK_CE(v, 2, 9); TK_CE(v, 3, 4); TK_CE(v, 6, 13); TK_CE(v, 8, 14); TK_CE(v, 10, 15); TK_CE(v, 11, 12);
    TK_CE(v, 0, 1); TK_CE(v, 2, 3); TK_CE(v, 4, 5); TK_CE(v, 6, 8); TK_CE(v, 7, 9); TK_CE(v, 10, 11); TK_CE(v, 12, 13); TK_CE(v, 14, 15);
    TK_CE(v, 0, 2); TK_CE(v, 1, 3); TK_CE(v, 4, 10); TK_CE(v, 5, 11); TK_CE(v, 6, 7); TK_CE(v, 8, 9); TK_CE(v, 12, 14); TK_CE(v, 13, 15);
    TK_CE(v, 1, 2); TK_CE(v, 3, 12); TK_CE(v, 4, 6); TK_CE(v, 5, 7); TK_CE(v, 8, 10); TK_CE(v, 9, 11); TK_CE(v, 13, 14);
    TK_CE(v, 1, 4); TK_CE(v, 2, 6); TK_CE(v, 5, 8); TK_CE(v, 7, 10); TK_CE(v, 9, 13); TK_CE(v, 11, 14);
    TK_CE(v, 2, 4); TK_CE(v, 3, 6); TK_CE(v, 9, 12); TK_CE(v, 11, 13);
    TK_CE(v, 3, 5); TK_CE(v, 6, 8); TK_CE(v, 7, 9); TK_CE(v, 10, 12);
    TK_CE(v, 3, 4); TK_CE(v, 5, 6); TK_CE(v, 7, 8); TK_CE(v, 9, 10); TK_CE(v, 11, 12);
    TK_CE(v, 6, 7); TK_CE(v, 8, 9);
#undef TK_L
}
__device__ __forceinline__ void tk_bitonic16(unsigned (&a)[16]) {
#pragma unroll
    for (int j = 8; j >= 1; j >>= 1)
#pragma unroll
        for (int i = 0; i < 16; ++i) { const int l = i ^ j; if (l > i) TK_CE(a, i, l); }
}
__device__ __forceinline__ void tk_merge16(unsigned (&a)[16], const unsigned (&b)[16]) {
#pragma unroll
    for (int i = 0; i < 16; ++i) a[i] = max(a[i], b[15 - i]);
#pragma unroll
    for (int j = 8; j >= 1; j >>= 1)
#pragma unroll
        for (int i = 0; i < 16; ++i) { const int l = i ^ j; if (l > i) TK_CE(a, i, l); }
}

__device__ __forceinline__ void topk_item(const unsigned short* __restrict__ ST, const float* __restrict__ sumsq, int* __restrict__ idx, float* __restrict__ gate, unsigned* L, int item, int tid, int lane) {
    {
        const int tt = item >> 3, h = item & 7;
        const float rs = rsqrtf(sumsq[tt * 64 + lane] * (1.0f / DM) + 1e-6f);
        const unsigned short* sp = ST + (((size_t)tt * 512 + h * 64) * 64 + lane) * 4;
        unsigned a0[16], a1[16];
#pragma unroll
        for (int s = 0; s < 16; ++s) { a0[s] = 0u; a1[s] = 0u; }
        unsigned bufk[3][16];
#define TK_LOAD(B, BLK) do { _Pragma("unroll") for (int i = 0; i < 8; ++i) { const u32x2 v = *(const u32x2*)(sp + (size_t)((BLK) * 8 + i) * 256); B[2 * i] = v.x; B[2 * i + 1] = v.y; } } while (0)
        TK_LOAD(bufk[0], 0); TK_LOAD(bufk[1], 1);
#pragma unroll
        for (int blk = 0; blk < 8; ++blk) {
            if (blk < 6) TK_LOAD(bufk[(blk + 2) % 3], blk + 2);
#pragma unroll
            for (int hb = 0; hb < 2; ++hb) {
                unsigned b16[16];
#pragma unroll
                for (int i = 0; i < 16; ++i) { const unsigned wv = bufk[blk % 3][8 * hb + (i >> 1)]; const unsigned ix = (unsigned)(127 - ((blk & 3) * 32 + 16 * hb + i));
                    b16[i] = (i & 1) ? ((wv & 0xffff0000u) | ix) : ((wv << 16) | ix); }
                tk_sort16(b16);
                if (blk < 4) { if (blk == 0 && hb == 0) {
#pragma unroll
                        for (int i = 0; i < 16; ++i) a0[i] = b16[i]; } else tk_merge16(a0, b16); }
                else { if (blk == 4 && hb == 0) {
#pragma unroll
                        for (int i = 0; i < 16; ++i) a1[i] = b16[i]; } else tk_merge16(a1, b16); }
            }
        }
#undef TK_LOAD
#pragma unroll
        for (int s = 0; s < 16; ++s) { L[s * 512 + tid] = a0[s]; L[(16 + s) * 512 + tid] = a1[s]; }
        unsigned c[16];
#pragma unroll
        for (int s = 0; s < 16; ++s) { const float sm = ord_val16(a0[0]) + ord_val16(a1[s]); c[s] = (ord_key(sm) & ~255u) | (unsigned)(255 - s); }
        {
            unsigned cb[16];
#pragma unroll
            for (int s = 0; s < 8; ++s) {
                const float s1 = ord_val16(a0[1]) + ord_val16(a1[s]), s2 = ord_val16(a0[15 - s]) + ord_val16(a1[0]);
                cb[s] = (ord_key(s1) & ~255u) | (unsigned)(255 - (16 + s)); cb[8 + s] = (ord_key(s2) & ~255u) | (unsigned)(255 - ((15 - s) * 16));
            }
            tk_bitonic16(cb); tk_merge16(c, cb);
        }
#pragma unroll
        for (int ri = 2; ri < 8; ++ri)
#pragma unroll
            for (int rj = 0; rj < 16; ++rj)
                if ((ri + 1) * (rj + 1) <= 16) { const float sm = ord_val16(a0[ri]) + ord_val16(a1[rj]); const unsigned k = (ord_key(sm) & ~255u) | (unsigned)(255 - (ri * 16 + rj)); INS16(c, k); }
        float sv[16]; int ei[16]; float mx = -INFINITY;
#pragma unroll
        for (int s = 0; s < 16; ++s) {
            const unsigned code = 255u - (c[s] & 255u); const unsigned k0 = L[(code >> 4) * 512 + tid], k1 = L[(16 + (code & 15)) * 512 + tid];
            sv[s] = (ord_val16(k0) + ord_val16(k1)) * rs; ei[s] = (int)((127u - (k0 & 127u)) * 128u + (127u - (k1 & 127u))); mx = fmaxf(mx, sv[s]);
        }
        float sum = 0.f;
#pragma unroll
        for (int s = 0; s < 16; ++s) { sv[s] = __expf(sv[s] - mx); sum += sv[s]; }
        const float inv = 1.0f / sum; const size_t ob = ((size_t)tt * 64 + lane) * 128 + h * 16;
#pragma unroll
        for (int s = 0; s < 16; s += 4) {
            *(int4*)(idx + ob + s) = make_int4(ei[s], ei[s + 1], ei[s + 2], ei[s + 3]);
            *(f32x4*)(gate + ob + s) = (f32x4){sv[s] * inv, sv[s + 1] * inv, sv[s + 2] * inv, sv[s + 3] * inv};
        }
    }
}

__device__ __forceinline__ float dot2bf(unsigned a, unsigned b, float c) { return __builtin_amdgcn_fdot2_f32_bf16(__builtin_bit_cast(bf16x2v, a), __builtin_bit_cast(bf16x2v, b), c, false); }

template <int MODE>
__device__ __forceinline__ void phase_expert(const bf16_t* __restrict__ XB, const float* __restrict__ sumsq, const int* __restrict__ idx, const float* __restrict__ gate,
                                             const bf16_t* __restrict__ Ut, const bf16_t* __restrict__ Vt, float* __restrict__ x, const float* __restrict__ gnext,
                                             bf16_t* __restrict__ XBout, int gw, int nw, int lane, bool dry) {
    for (int t0 = gw; t0 < T_TOK; t0 += nw) {
        const int t = __builtin_amdgcn_readfirstlane(t0);
        const u32x4 xa = *(const u32x4*)(XB + (size_t)t * DM + lane * 16), xb = *(const u32x4*)(XB + (size_t)t * DM + lane * 16 + 8);
        const float rs = rsqrtf(sumsq[t] * (1.0f / DM) + 1e-6f);
        float y[16];
#pragma unroll
        for (int i = 0; i < 16; ++i) y[i] = 0.f;
        const int myp = (lane >> 3) & 7;
#pragma unroll 1
        for (int grp = 0; grp < 16; ++grp) {
            const int* ip = idx + (size_t)t * 128 + grp * 8;
            int e[8];
#pragma unroll
            for (int k = 0; k < 8; ++k) e[k] = __builtin_amdgcn_readfirstlane(ip[k]);
            u32x4 ua[8], ub[8];
#pragma unroll
            for (int k = 0; k < 8; ++k) { const bf16_t* up = Ut + (size_t)e[k] * DM + lane * 16; ua[k] = *(const u32x4*)up; ub[k] = *(const u32x4*)(up + 8); }
            float d[8];
#pragma unroll
            for (int k = 0; k < 8; ++k) {
                float s0 = dot2bf(ua[k].x, xa.x, 0.f), s1 = dot2bf(ua[k].y, xa.y, 0.f);
                s0 = dot2bf(ua[k].z, xa.z, s0); s1 = dot2bf(ua[k].w, xa.w, s1);
                s0 = dot2bf(ub[k].x, xb.x, s0); s1 = dot2bf(ub[k].y, xb.y, s1);
                s0 = dot2bf(ub[k].z, xb.z, s0); s1 = dot2bf(ub[k].w, xb.w, s1);
                d[k] = s0 + s1;
            }
            float r4[4], r2[2], r1;
            { const bool hi = (lane & 32) != 0;
#pragma unroll
              for (int i = 0; i < 4; ++i) { const float keep = hi ? d[i + 4] : d[i], send = hi ? d[i] : d[i + 4]; r4[i] = keep + __shfl_xor(send, 32); } }
            { const bool hi = (lane & 16) != 0;
#pragma unroll
              for (int i = 0; i < 2; ++i) { const float keep = hi ? r4[i + 2] : r4[i], send = hi ? r4[i] : r4[i + 2]; r2[i] = keep + __shfl_xor(send, 16); } }
            { const bool hi = (lane & 8) != 0; const float keep = hi ? r2[1] : r2[0], send = hi ? r2[0] : r2[1]; r1 = keep + __shfl_xor(send, 8); }
            r1 += __shfl_xor(r1, 4); r1 += __shfl_xor(r1, 2); r1 += __shfl_xor(r1, 1);
            const int pk = ((lane >> 5) & 1) * 4 + ((lane >> 4) & 1) * 2 + ((lane >> 3) & 1);
            const float gk = gate[(size_t)t * 128 + grp * 8 + pk];
            const float wgt = gk * gelu_t(r1 * rs);
            (void)myp;
#pragma unroll
            for (int k = 0; k < 8; ++k) {
                const float wk = __uint_as_float(__builtin_amdgcn_readlane(__float_as_uint(wgt), ((k >> 2) & 1) * 32 + ((k >> 1) & 1) * 16 + (k & 1) * 8));
                const bf16_t* vp = Vt + (size_t)e[k] * DM + lane * 16;
                const u32x4 va = *(const u32x4*)vp, vb = *(const u32x4*)(vp + 8);
                y[0] += wk * bf_lo(va.x); y[1] += wk * bf_hi(va.x); y[2] += wk * bf_lo(va.y); y[3] += wk * bf_hi(va.y);
                y[4] += wk * bf_lo(va.z); y[5] += wk * bf_hi(va.z); y[6] += wk * bf_lo(va.w); y[7] += wk * bf_hi(va.w);
                y[8] += wk * bf_lo(vb.x); y[9] += wk * bf_hi(vb.x); y[10] += wk * bf_lo(vb.y); y[11] += wk * bf_hi(vb.y);
                y[12] += wk * bf_lo(vb.z); y[13] += wk * bf_hi(vb.z); y[14] += wk * bf_lo(vb.w); y[15] += wk * bf_hi(vb.w);
            }
        }
        float* xr = x + (size_t)t * DM + lane * 16; float ss = 0.f; f32x4 xn[4];
#pragma unroll
        for (int i = 0; i < 4; ++i) { const f32x4 xv = *(const f32x4*)(xr + 4 * i); xn[i] = xv + (f32x4){y[4 * i], y[4 * i + 1], y[4 * i + 2], y[4 * i + 3]};
            ss += (xn[i][0] * xn[i][0] + xn[i][1] * xn[i][1]) + (xn[i][2] * xn[i][2] + xn[i][3] * xn[i][3]); }
        ss = wave_sum(ss); const float rn = rsqrtf(ss * (1.0f / DM) + 1e-6f);
        if (dry) continue;
        if (MODE == 0) {
            u32x4 o[2];
#pragma unroll
            for (int i = 0; i < 4; ++i) { *(f32x4*)(xr + 4 * i) = xn[i]; const f32x4 gv = *(const f32x4*)(gnext + lane * 16 + 4 * i); const f32x4 r = xn[i] * gv * rn;
                const unsigned a = cvt_pk_bf16(r[0], r[1]), b = cvt_pk_bf16(r[2], r[3]);
                if ((i & 1) == 0) { o[i >> 1].x = a; o[i >> 1].y = b; } else { o[i >> 1].z = a; o[i >> 1].w = b; } }
            *(u32x4*)(XBout + (size_t)t * DM + lane * 16) = o[0]; *(u32x4*)(XBout + (size_t)t * DM + lane * 16 + 8) = o[1];
        } else {
#pragma unroll
            for (int i = 0; i < 4; ++i) { const f32x4 gv = *(const f32x4*)(gnext + lane * 16 + 4 * i); *(f32x4*)(xr + 4 * i) = xn[i] * gv * rn; }
        }
    }
}

__device__ __forceinline__ void phase_topk_own(const unsigned short* __restrict__ ST, const float* __restrict__ sumsq, int* __restrict__ idx, float* __restrict__ gate, unsigned char* smem, const pg8::StaticOrder& S) {
    asm volatile("s_waitcnt vmcnt(0)" ::: "memory");
    __syncthreads();
    __builtin_amdgcn_fence(__ATOMIC_ACQUIRE, "agent");
    asm volatile("s_waitcnt vmcnt(0)" ::: "memory");
    int tid_ = threadIdx.x; asm volatile("" : "+v"(tid_));
    const int tid = tid_, lane = tid & 63, w = __builtin_amdgcn_readfirstlane(tid >> 6);
#pragma unroll 1
    for (int li = w;; li += 8) { pg8::Unit u; if (!S.next(li >> 2, u)) break;
        topk_item(ST, sumsq, idx, gate, (unsigned*)smem, (u.pm * 4 + (li & 3)) * 8 + u.pn, tid, lane); }
    __syncthreads();
}
__device__ __forceinline__ void pro_s5(const float* __restrict__ lre, const float* __restrict__ lim, const float* __restrict__ bre, const float* __restrict__ bim,
                                       const float* __restrict__ cre, const float* __restrict__ cim, const float* __restrict__ lstep,
                                       bf16_t* __restrict__ Ktab, bf16_t* __restrict__ ME, bf16_t* __restrict__ MY, float* __restrict__ lam64, unsigned char* smem, int tid) {
    float2* LP = (float2*)smem;
    float2* BB = (float2*)(smem + 33280);
    float2* CC = (float2*)(smem + 33280 + 8192);
    for (int gi = blockIdx.x; gi < 256; gi += gridDim.x) {
        const int g = gi >> 2, part = gi & 3;
        __syncthreads();
        const float dt = expf(lstep[g]);
        for (int e = tid; e < 65 * 64; e += 512) {
            const int n = e >> 6, p = e & 63; const float lr = lre[g * 64 + p], li = lim[g * 64 + p];
            double rev = (double)li * (double)dt * (double)n * 0.15915494309189535; rev -= floor(rev);
            const float rv = (float)rev; const float mg = expf(lr * dt * (float)n);
            LP[e] = make_float2(mg * __builtin_amdgcn_cosf(rv), mg * __builtin_amdgcn_sinf(rv));
        }
        for (int e = tid; e < 1024; e += 512) {
            const int p = e >> 4, c = e & 15; const float lr = lre[g * 64 + p], li = lim[g * 64 + p];
            const float decay = expf(lr * dt), ar = decay * cosf(li * dt), ai = decay * sinf(li * dt), mag = lr * lr + li * li;
            const float kr = ((ar - 1.0f) * lr + ai * li) / mag, ki = (ai * lr - (ar - 1.0f) * li) / mag;
            const float br = bre[(g * 64 + p) * 16 + c], bi = bim[(g * 64 + p) * 16 + c];
            BB[e] = make_float2(kr * br - ki * bi, kr * bi + ki * br);
            const int c2 = e >> 6, p2 = e & 63;
            CC[e] = make_float2(cre[(g * 16 + c2) * 64 + p2], cim[(g * 16 + c2) * 64 + p2]);
        }
        __syncthreads();
        {
            const int lane = tid & 63, cq = lane & 15, kq = lane >> 4, w = tid >> 6;
            float2 bb[16], cc[16];
#pragma unroll
            for (int st = 0; st < 16; ++st) { bb[st] = BB[(4 * st + kq) * 16 + cq]; cc[st] = CC[cq * 64 + 4 * st + kq]; }
#pragma unroll 1
            for (int i = 0; i < 2; ++i) {
                const int tau = part + 4 * (w + 8 * i);
                f32x4 acc = (f32x4){0.f, 0.f, 0.f, 0.f};
#pragma unroll
                for (int st = 0; st < 16; ++st) {
                    const float2 L = LP[tau * 64 + 4 * st + kq];
                    const float wr_ = cc[st].x * L.x - cc[st].y * L.y, wi_ = cc[st].x * L.y + cc[st].y * L.x;
                    acc = __builtin_amdgcn_mfma_f32_16x16x4f32(bb[st].x, wr_, acc, 0, 0, 0);
                    acc = __builtin_amdgcn_mfma_f32_16x16x4f32(bb[st].y, -wi_, acc, 0, 0, 0);
                }
                u32x2 o; o.x = cvt_pk_bf16(acc[0], acc[1]); o.y = cvt_pk_bf16(acc[2], acc[3]);
                *(u32x2*)(Ktab + (size_t)g * (65 * 256) + (tau + 1) * 256 + cq * 16 + 4 * kq) = o;
            }
            if (part == 0 && tid < 128) *(unsigned*)(Ktab + (size_t)g * (65 * 256) + 2 * tid) = 0u;
        }
        for (int it = 0; it < 8; ++it) {
            const int q = tid + 512 * (part + 4 * it), row = q >> 7, oct = q & 127, ri = row >> 6, p = row & 63, j = oct >> 1, c1b = 8 * (oct & 1);
            const float2 L = LP[(63 - j) * 64 + p]; float v[8];
#pragma unroll
            for (int e = 0; e < 8; ++e) { const float2 B = BB[p * 16 + c1b + e]; v[e] = ri == 0 ? (L.x * B.x - L.y * B.y) : (L.x * B.y + L.y * B.x); }
            *(bf16x8*)(ME + (size_t)g * (128 * 1024) + ((((row >> 5) * 64 + j) * 64 + (row & 31) + 32 * (oct & 1)) << 3)) = pack8(v[0], v[1], v[2], v[3], v[4], v[5], v[6], v[7]);
        }
        for (int it = 0; it < 8; ++it) {
            const int q = tid + 512 * (part + 4 * it), row = q >> 4, oct = q & 15, t = row >> 4, c = row & 15, ri = oct >> 3, p0 = 8 * (oct & 7);
            float v[8];
#pragma unroll
            for (int e = 0; e < 8; ++e) { const float2 C = CC[c * 64 + p0 + e], L = LP[(t + 1) * 64 + p0 + e]; v[e] = ri == 0 ? (C.x * L.x - C.y * L.y) : -(C.x * L.y + C.y * L.x); }
            *(bf16x8*)(MY + (size_t)g * (1024 * 128) + ((((row >> 5) * 8 + (oct >> 1)) * 64 + (row & 31) + 32 * (oct & 1)) << 3)) = pack8(v[0], v[1], v[2], v[3], v[4], v[5], v[6], v[7]);
        }
        if (tid < 64 && part == 0) { const float2 L = LP[64 * 64 + tid]; lam64[(g * 64 + tid) * 2] = L.x; lam64[(g * 64 + tid) * 2 + 1] = L.y; }
    }
}

__device__ __forceinline__ void phase_s5(const bf16_t* __restrict__ HN, const bf16_t* __restrict__ Ktab, const bf16_t* __restrict__ ME, const bf16_t* __restrict__ MY,
                                         const float* __restrict__ lam64, const float* __restrict__ s5d, bf16_t* __restrict__ GBUF, unsigned char* smem, int mode) {
    bf16_t* Ks = (bf16_t*)smem;
    unsigned char* Us = smem + 33280;
    float* Es = (float*)(smem + 33280 + 66560);
    bf16_t* Ss = (bf16_t*)(smem + 33280 + 66560 + 32768);
    const int w = __builtin_amdgcn_readfirstlane(threadIdx.x >> 6);
    int curg = -1;
    const int nbs = (int)gridDim.x, vb = (nbs & 7) ? (int)blockIdx.x : (((int)blockIdx.x & 7) * (nbs >> 3) + ((int)blockIdx.x >> 3));
    for (int it = vb * 4; it < 1024; it += nbs * 4)
        for (int k4 = 0; k4 < 4; ++k4) {
            int tid_ = threadIdx.x; asm volatile("" : "+v"(tid_));
            const int tid = tid_, lane = tid & 63, r = lane & 31, half = lane >> 5;
            const int item = it + k4, g = item >> 4, b = item & 15;
            __syncthreads();
            if (g != curg) {
                u32x4 kv[5];
#pragma unroll
                for (int q = 0; q < 5; ++q) { const int e = tid + 512 * q; if (e < 2080) kv[q] = *(const u32x4*)(Ktab + (size_t)g * (65 * 256) + e * 8); }
#pragma unroll
                for (int q = 0; q < 5; ++q) { const int e = tid + 512 * q; if (e < 2080) *(u32x4*)(Ks + e * 8) = kv[q]; }
                curg = g; }
            const int rb = w & 3, jh = w >> 2;
            const bf16_t* mp = ME + (size_t)g * (128 * 1024) + (size_t)((rb * 64 + 32 * jh) * 64 + lane) * 8;
            u32x4 ha[4], hc[4]; bf16x8 af[2][8];
#pragma unroll
            for (int i = 0; i < 4; ++i) { const int tk = tid + 512 * i; const bf16_t* src = HN + (((size_t)b * 64 + g) * SEQ + tk) * 16;
                ha[i] = *(const u32x4*)src; hc[i] = *(const u32x4*)(src + 8); }
#pragma unroll
            for (int jj = 0; jj < 8; ++jj) { af[0][jj] = *(const bf16x8*)(mp + 512 * jj); af[1][jj] = *(const bf16x8*)(mp + 512 * (8 + jj)); }
#pragma unroll
            for (int i = 0; i < 4; ++i) { const int tk = tid + 512 * i; unsigned char* dst = Us + (tk >> 6) * 2080 + (tk & 63) * 32; *(u32x4*)dst = ha[i]; *(u32x4*)(dst + 16) = hc[i]; }
            __builtin_amdgcn_sched_group_barrier(0x020, 24, 0);
            __builtin_amdgcn_sched_group_barrier(0x200, 8, 0);
            __syncthreads();
            if (mode == 1) continue;
            {
                f32x16 acc;
#pragma unroll
                for (int i = 0; i < 16; ++i) acc[i] = 0.f;
                const unsigned char* up = Us + r * 2080 + 16 * half + 1024 * jh;
#pragma unroll
                for (int c = 0; c < 4; ++c) {
#pragma unroll
                    for (int jj = 0; jj < 8; ++jj) { const bf16x8 bq = *(const bf16x8*)(up + (8 * c + jj) * 32); acc = MFMA32(af[c & 1][jj], bq, acc); }
                    if (c < 2) {
#pragma unroll
                        for (int jj = 0; jj < 8; ++jj) af[c & 1][jj] = *(const bf16x8*)(mp + 512 * (8 * (c + 2) + jj));
                    }
                }
                __builtin_amdgcn_sched_group_barrier(0x008, 8, 0); __builtin_amdgcn_sched_group_barrier(0x020, 8, 0);
                __builtin_amdgcn_sched_group_barrier(0x008, 8, 0); __builtin_amdgcn_sched_group_barrier(0x020, 8, 0);
                __builtin_amdgcn_sched_group_barrier(0x008, 16, 0);
#pragma unroll
                for (int i = 0; i < 16; ++i) Es[jh * 4096 + r * 128 + 32 * rb + (i & 3) + 8 * (i >> 2) + 4 * half] = acc[i];
            }
            __syncthreads();
            if (tid < 64) {
                const float lr = lam64[(g * 64 + tid) * 2], li = lam64[(g * 64 + tid) * 2 + 1]; float sr = 0.f, si = 0.f;
                float er[32], ei[32];
#pragma unroll
                for (int n = 0; n < 32; ++n) { er[n] = Es[n * 128 + tid] + Es[4096 + n * 128 + tid]; ei[n] = Es[n * 128 + 64 + tid] + Es[4096 + n * 128 + 64 + tid]; }
#pragma unroll
                for (int n = 0; n < 32; ++n) {
                    Ss[n * 136 + tid] = (bf16_t)(cvt_pk_bf16(sr, 0.f) & 0xffffu); Ss[n * 136 + 64 + tid] = (bf16_t)(cvt_pk_bf16(si, 0.f) & 0xffffu);
                    const float nr = lr * sr - li * si + er[n], ni = lr * si + li * sr + ei[n]; sr = nr; si = ni;
                }
            }
            __syncthreads();
            if (mode == 2) continue;
            f32x16 acc[4];
#pragma unroll
            for (int q = 0; q < 4; ++q)
#pragma unroll
                for (int i = 0; i < 16; ++i) acc[q][i] = 0.f;
            {
                const unsigned char* up = Us + r * 2080 + 16 * half;
                const bf16_t* kp = Ks + r * 16 + 8 * half;
                bf16x8 mya[4][4], myb[4][4];
#pragma unroll
                for (int ks = 0; ks < 4; ++ks)
#pragma unroll
                    for (int q = 0; q < 4; ++q) mya[ks][q] = *(const bf16x8*)(MY + (size_t)g * (1024 * 128) + (size_t)(((w + 8 * q) * 8 + ks) * 64 + lane) * 8);
#pragma unroll 2
                for (int j = 0; j < 64; ++j) {
                    const bf16x8 bq = *(const bf16x8*)(up + j * 32);
#pragma unroll
                    for (int q = 0; q < 4; ++q) { const int tbk = w + 8 * q; if (2 * tbk + 1 >= j) { const int d = 2 * tbk - j; const bf16x8 a = *(const bf16x8*)(kp + (d + 1) * 256); acc[q] = MFMA32(a, bq, acc[q]); } }
                }
#pragma unroll
                for (int ks = 0; ks < 4; ++ks)
#pragma unroll
                    for (int q = 0; q < 4; ++q) myb[ks][q] = *(const bf16x8*)(MY + (size_t)g * (1024 * 128) + (size_t)(((w + 8 * q) * 8 + 4 + ks) * 64 + lane) * 8);
                const bf16_t* sp = Ss + r * 136 + 8 * half;
#pragma unroll
                for (int ks = 0; ks < 4; ++ks) { const bf16x8 bq = *(const bf16x8*)(sp + 16 * ks);
#pragma unroll
                    for (int q = 0; q < 4; ++q) acc[q] = MFMA32(mya[ks][q], bq, acc[q]); }
#pragma unroll
                for (int ks = 0; ks < 4; ++ks) { const bf16x8 bq = *(const bf16x8*)(sp + 16 * (4 + ks));
#pragma unroll
                    for (int q = 0; q < 4; ++q) acc[q] = MFMA32(myb[ks][q], bq, acc[q]); }
            }
            if (mode == 3) { asm volatile("" :: "v"(acc[0][0]), "v"(acc[1][5]), "v"(acc[2][9]), "v"(acc[3][15])); continue; }
            __syncthreads();
#pragma unroll
            for (int q = 0; q < 4; ++q) {
                const int tbk = w + 8 * q;
#pragma unroll
                for (int gi = 0; gi < 4; ++gi) {
                    const int tl = 2 * tbk + (gi >> 1), cb = 8 * (gi & 1) + 4 * half;
                    unsigned char* lp_ = Us + r * 2080 + tl * 32 + cb * 2;
                    const u32x2 hv = *(const u32x2*)lp_;
                    const f32x4 dv = *(const f32x4*)(s5d + g * 16 + cb);
                    const float y0 = acc[q][4 * gi] + dv[0] * bf_lo(hv.x), y1 = acc[q][4 * gi + 1] + dv[1] * bf_hi(hv.x), y2 = acc[q][4 * gi + 2] + dv[2] * bf_lo(hv.y), y3 = acc[q][4 * gi + 3] + dv[3] * bf_hi(hv.y);
                    u32x2 o; o.x = cvt_pk_bf16(gelu_t(y0), gelu_t(y1)); o.y = cvt_pk_bf16(gelu_t(y2), gelu_t(y3));
                    *(u32x2*)lp_ = o;
                }
            }
            __syncthreads();
#pragma unroll
            for (int i = 0; i < 4; ++i) { const int tk = tid + 512 * i; bf16_t* dst = GBUF + ((size_t)b * SEQ + tk) * DM + g * 16;
                const unsigned char* src = Us + (tk >> 6) * 2080 + (tk & 63) * 32; *(u32x4*)dst = *(const u32x4*)src; *(u32x4*)(dst + 8) = *(const u32x4*)(src + 16); }
        }
}

struct EpiGlu {
    const bf16_t* GB; const float* bias; float* x; bf16_t* XB; float* sumsq; bool dry;
    static constexpr bool PERM = false, AFTER_DRAIN = false;
    __device__ __forceinline__ void operator()(const acc_t& acc, const pg8::Unit& u, int wr, int wc, int fr_, int fq_) const {
        const int pm = u.pm, pn = u.pn; int fr = fr_, fq = fq_; asm volatile("" : "+v"(fr), "+v"(fq));
        float ssq_[2][4];
#pragma unroll
        for (int ai = 0; ai < 2; ++ai) {
            u32x2 xr2[4][2][2], gr2[4][2][2];
#pragma unroll
            for (int m = 0; m < 4; ++m)
#pragma unroll
                for (int bj = 0; bj < 2; ++bj)
#pragma unroll
                    for (int n = 0; n < 2; ++n) { const size_t off = (size_t)(pm * 256 + ai * 128 + wr * 64 + m * 16 + fr) * DM + pn * 256 + bj * 128 + wc * 32 + n * 16 + fq * 4;
                        xr2[m][bj][n] = *(const u32x2*)((const bf16_t*)x + off); gr2[m][bj][n] = *(const u32x2*)(GB + off); }
            float ss[4] = {0.f, 0.f, 0.f, 0.f};
#pragma unroll
            for (int bj = 0; bj < 2; ++bj)
#pragma unroll
                for (int n = 0; n < 2; ++n) {
                    const int col = pn * 256 + bj * 128 + wc * 32 + n * 16 + fq * 4;
                    const f32x4 bv = *(const f32x4*)(bias + col);
#pragma unroll
                    for (int m = 0; m < 4; ++m) {
                        const int t = pm * 256 + ai * 128 + wr * 64 + m * 16 + fr; const size_t off = (size_t)t * DM + col;
                        const u32x2 xq2 = xr2[m][bj][n], gr = gr2[m][bj][n];
                        const f32x4 xv = (f32x4){bf_lo(xq2.x), bf_hi(xq2.x), bf_lo(xq2.y), bf_hi(xq2.y)};
                        const f32x4 a = acc[ai][bj][m][n] + bv; f32x4 v;
                        v[0] = xv[0] + bf_lo(gr.x) * __builtin_amdgcn_rcpf(1.0f + __expf(-a[0])); v[1] = xv[1] + bf_hi(gr.x) * __builtin_amdgcn_rcpf(1.0f + __expf(-a[1]));
                        v[2] = xv[2] + bf_lo(gr.y) * __builtin_amdgcn_rcpf(1.0f + __expf(-a[2])); v[3] = xv[3] + bf_hi(gr.y) * __builtin_amdgcn_rcpf(1.0f + __expf(-a[3]));
                        u32x2 wv; wv.x = cvt_pk_bf16(v[0], v[1]); wv.y = cvt_pk_bf16(v[2], v[3]);
                        if (!dry) *(u32x2*)(XB + off) = wv;
                        ss[m] += (v[0] * v[0] + v[1] * v[1]) + (v[2] * v[2] + v[3] * v[3]);
                    }
                }
#pragma unroll
            for (int m = 0; m < 4; ++m) { float s1 = ss[m]; s1 += __shfl_xor(s1, 16); s1 += __shfl_xor(s1, 32); ssq_[ai][m] = s1; }
            __builtin_amdgcn_sched_barrier(0);
        }
        if (fq == 0 && !dry) {
#pragma unroll
            for (int ai = 0; ai < 2; ++ai)
#pragma unroll
                for (int m = 0; m < 4; ++m) atomicAdd(sumsq + pm * 256 + ai * 128 + wr * 64 + m * 16 + fr, ssq_[ai][m]);
        }
    }
};
typedef float f32x2 __attribute__((ext_vector_type(2)));
__device__ __forceinline__ void pro_table8(const float* __restrict__ src, const float* __restrict__ g, unsigned char* __restrict__ T8, float* __restrict__ S, int gw, int nw, int lane) {
    for (int e = gw; e < 16384; e += nw) {
        const float* rp = src + (size_t)e * DM + lane * 16; f32x4 v[4]; float mx = 0.f;
#pragma unroll
        for (int i = 0; i < 4; ++i) { v[i] = *(const f32x4*)(rp + 4 * i); if (g) v[i] = v[i] * *(const f32x4*)(g + lane * 16 + 4 * i);
            mx = fmaxf(mx, fmaxf(fmaxf(fabsf(v[i][0]), fabsf(v[i][1])), fmaxf(fabsf(v[i][2]), fabsf(v[i][3])))); }
#pragma unroll
        for (int o = 32; o > 0; o >>= 1) mx = fmaxf(mx, __shfl_xor(mx, o));
        const float s = mx > 0.f ? mx * (1.0f / 448.0f) : 1.0f, inv = 1.0f / s;
        u32x4 q;
#pragma unroll
        for (int i = 0; i < 4; ++i) { int w = __builtin_amdgcn_cvt_pk_fp8_f32(v[i][0] * inv, v[i][1] * inv, 0, false); w = __builtin_amdgcn_cvt_pk_fp8_f32(v[i][2] * inv, v[i][3] * inv, w, true); q[i] = (unsigned)w; }
        *(u32x4*)(T8 + (size_t)e * DM + lane * 16) = q;
        if (lane == 0) S[e] = s;
    }
}

template <int MODE>
__device__ __forceinline__ void phase_expert8(const bf16_t* __restrict__ XB, const float* __restrict__ sumsq, const int* __restrict__ idx, const float* __restrict__ gate,
                                              const unsigned char* __restrict__ Ut, const unsigned char* __restrict__ Vt, const float* __restrict__ SU, const float* __restrict__ SV,
                                              float* __restrict__ x, const float* __restrict__ gnext, bf16_t* __restrict__ XBout, int gw, int nw, int lane, bool dry) {
    const int pk = ((lane >> 5) & 1) * 4 + ((lane >> 4) & 1) * 2 + ((lane >> 3) & 1);
    for (int t0 = gw; t0 < T_TOK; t0 += nw) {
        const int t = __builtin_amdgcn_readfirstlane(t0);
        const u32x4 xa = *(const u32x4*)(XB + (size_t)t * DM + lane * 16), xb = *(const u32x4*)(XB + (size_t)t * DM + lane * 16 + 8);
        const f32x2 x2[8] = {{bf_lo(xa.x), bf_hi(xa.x)}, {bf_lo(xa.y), bf_hi(xa.y)}, {bf_lo(xa.z), bf_hi(xa.z)}, {bf_lo(xa.w), bf_hi(xa.w)},
                             {bf_lo(xb.x), bf_hi(xb.x)}, {bf_lo(xb.y), bf_hi(xb.y)}, {bf_lo(xb.z), bf_hi(xb.z)}, {bf_lo(xb.w), bf_hi(xb.w)}};
        const float rs = rsqrtf(sumsq[t] * (1.0f / DM) + 1e-6f);
        f32x2 y2[8];
#pragma unroll
        for (int i = 0; i < 8; ++i) y2[i] = (f32x2){0.f, 0.f};
#pragma unroll 1
        for (int grp = 0; grp < 16; ++grp) {
            const int* ip = idx + (size_t)t * 128 + grp * 8;
            int e[8];
#pragma unroll
            for (int k = 0; k < 8; ++k) e[k] = __builtin_amdgcn_readfirstlane(ip[k]);
            u32x4 uq[8], vq[8];
#pragma unroll
            for (int k = 0; k < 8; ++k) uq[k] = *(const u32x4*)(Ut + (size_t)e[k] * DM + lane * 16);
#pragma unroll
            for (int k = 0; k < 8; ++k) vq[k] = *(const u32x4*)(Vt + (size_t)e[k] * DM + lane * 16);
            const int emy = ip[pk]; const float wsc = gate[(size_t)t * 128 + grp * 8 + pk] * SV[emy], usc = SU[emy] * rs;
            float d[8];
#pragma unroll
            for (int k = 0; k < 8; ++k) {
                f32x2 a0 = (f32x2){0.f, 0.f}, a1 = (f32x2){0.f, 0.f};
#pragma unroll
                for (int i = 0; i < 4; ++i) {
                    a0 = __builtin_elementwise_fma(__builtin_amdgcn_cvt_pk_f32_fp8((int)uq[k][i], false), x2[2 * i], a0);
                    a1 = __builtin_elementwise_fma(__builtin_amdgcn_cvt_pk_f32_fp8((int)uq[k][i], true), x2[2 * i + 1], a1);
                }
                d[k] = (a0.x + a0.y) + (a1.x + a1.y);
            }
            float r4[4], r2[2], r1;
            { const bool hi = (lane & 32) != 0;
#pragma unroll
              for (int i = 0; i < 4; ++i) { const float keep = hi ? d[i + 4] : d[i], send = hi ? d[i] : d[i + 4]; r4[i] = keep + __shfl_xor(send, 32); } }
            { const bool hi = (lane & 16) != 0;
#pragma unroll
              for (int i = 0; i < 2; ++i) { const float keep = hi ? r4[i + 2] : r4[i], send = hi ? r4[i] : r4[i + 2]; r2[i] = keep + __shfl_xor(send, 16); } }
            { const bool hi = (lane & 8) != 0; const float keep = hi ? r2[1] : r2[0], send = hi ? r2[0] : r2[1]; r1 = keep + __shfl_xor(send, 8); }
            r1 += __shfl_xor(r1, 4); r1 += __shfl_xor(r1, 2); r1 += __shfl_xor(r1, 1);
            const float wgt = wsc * gelu_t(r1 * usc);
#pragma unroll
            for (int k = 0; k < 8; ++k) {
                const float wk = __uint_as_float(__builtin_amdgcn_readlane(__float_as_uint(wgt), ((k >> 2) & 1) * 32 + ((k >> 1) & 1) * 16 + (k & 1) * 8));
                const f32x2 w2 = (f32x2){wk, wk};
#pragma unroll
                for (int i = 0; i < 4; ++i) {
                    y2[2 * i] = __builtin_elementwise_fma(__builtin_amdgcn_cvt_pk_f32_fp8((int)vq[k][i], false), w2, y2[2 * i]);
                    y2[2 * i + 1] = __builtin_elementwise_fma(__builtin_amdgcn_cvt_pk_f32_fp8((int)vq[k][i], true), w2, y2[2 * i + 1]);
                }
            }
        }
        if (dry) continue;
        float* xr = x + (size_t)t * DM + lane * 16; float ss = 0.f; f32x4 xn[4];
#pragma unroll
        for (int i = 0; i < 4; ++i) { const f32x4 xv = *(const f32x4*)(xr + 4 * i); xn[i] = xv + (f32x4){y2[2 * i].x, y2[2 * i].y, y2[2 * i + 1].x, y2[2 * i + 1].y};
            ss += (xn[i][0] * xn[i][0] + xn[i][1] * xn[i][1]) + (xn[i][2] * xn[i][2] + xn[i][3] * xn[i][3]); }
        ss = wave_sum(ss); const float rn = rsqrtf(ss * (1.0f / DM) + 1e-6f);
        if (MODE == 0) {
            u32x4 o[2];
#pragma unroll
            for (int i = 0; i < 4; ++i) { *(f32x4*)(xr + 4 * i) = xn[i]; const f32x4 gv = *(const f32x4*)(gnext + lane * 16 + 4 * i); const f32x4 r = xn[i] * gv * rn;
                const unsigned a = cvt_pk_bf16(r[0], r[1]), b = cvt_pk_bf16(r[2], r[3]);
                if ((i & 1) == 0) { o[i >> 1].x = a; o[i >> 1].y = b; } else { o[i >> 1].z = a; o[i >> 1].w = b; } }
            *(u32x4*)(XBout + (size_t)t * DM + lane * 16) = o[0]; *(u32x4*)(XBout + (size_t)t * DM + lane * 16 + 8) = o[1];
        } else {
#pragma unroll
            for (int i = 0; i < 4; ++i) { const f32x4 gv = *(const f32x4*)(gnext + lane * 16 + 4 * i); *(f32x4*)(xr + 4 * i) = xn[i] * gv * rn; }
        }
    }
}
typedef int v6i __attribute__((ext_vector_type(6)));
typedef float v32f __attribute__((ext_vector_type(32)));
typedef float v16f __attribute__((ext_vector_type(16)));
#define ROW6 768
__device__ __forceinline__ void pro_table6(const float* __restrict__ src, const float* __restrict__ g, unsigned char* __restrict__ T6, float* __restrict__ S, int gw, int nw, int lane) {
    const int lp = lane & 31, hf = lane >> 5;
    for (int e0 = gw * 4; e0 < 16384; e0 += nw * 4) {
        v16f a[2], b[2]; float mx[2];
#pragma unroll
        for (int u = 0; u < 2; ++u) {
            const float* rp = src + (size_t)(e0 + 2 * u + hf) * DM + lp * 32;
#pragma unroll
            for (int i = 0; i < 4; ++i) { const f32x4 v = *(const f32x4*)(rp + 4 * i); a[u][4 * i] = v[0]; a[u][4 * i + 1] = v[1]; a[u][4 * i + 2] = v[2]; a[u][4 * i + 3] = v[3]; }
#pragma unroll
            for (int i = 0; i < 4; ++i) { const f32x4 v = *(const f32x4*)(rp + 16 + 4 * i); b[u][4 * i] = v[0]; b[u][4 * i + 1] = v[1]; b[u][4 * i + 2] = v[2]; b[u][4 * i + 3] = v[3]; }
        }
        if (g) {
#pragma unroll
            for (int i = 0; i < 4; ++i) { const f32x4 g0 = *(const f32x4*)(g + lp * 32 + 4 * i), g1 = *(const f32x4*)(g + lp * 32 + 16 + 4 * i);
#pragma unroll
                for (int u = 0; u < 2; ++u) { a[u][4 * i] *= g0[0]; a[u][4 * i + 1] *= g0[1]; a[u][4 * i + 2] *= g0[2]; a[u][4 * i + 3] *= g0[3];
                    b[u][4 * i] *= g1[0]; b[u][4 * i + 1] *= g1[1]; b[u][4 * i + 2] *= g1[2]; b[u][4 * i + 3] *= g1[3]; } }
        }
#pragma unroll
        for (int u = 0; u < 2; ++u) { mx[u] = 0.f;
#pragma unroll
            for (int i = 0; i < 16; ++i) mx[u] = fmaxf(mx[u], fmaxf(fabsf(a[u][i]), fabsf(b[u][i]))); }
#pragma unroll
        for (int o = 16; o > 0; o >>= 1) { mx[0] = fmaxf(mx[0], __shfl_xor(mx[0], o)); mx[1] = fmaxf(mx[1], __shfl_xor(mx[1], o)); }
#pragma unroll
        for (int u = 0; u < 2; ++u) {
            const int e = e0 + 2 * u + hf;
            const float s = mx[u] > 0.f ? mx[u] * (1.0f / 7.5f) : 1.0f, inv = 1.0f / s;
            v16f ev, od;
#pragma unroll
            for (int i = 0; i < 8; ++i) { ev[i] = a[u][2 * i] * inv; od[i] = a[u][2 * i + 1] * inv; ev[8 + i] = b[u][2 * i] * inv; od[8 + i] = b[u][2 * i + 1] * inv; }
            const v6i q = __builtin_amdgcn_cvt_scalef32_2xpk16_fp6_f32(ev, od, 1.0f);
            unsigned char* row = T6 + (size_t)e * ROW6;
            *(u32x4*)(row + 16 * lp) = (u32x4){(unsigned)q[0], (unsigned)q[1], (unsigned)q[2], (unsigned)q[3]};
            *(u32x2*)(row + 512 + 8 * lp) = (u32x2){(unsigned)q[4], (unsigned)q[5]};
            if (lp == 0) S[e] = s;
        }
    }
}

template <int MODE>
__device__ __forceinline__ void phase_expert6(const bf16_t* __restrict__ XB, const float* __restrict__ sumsq, const int* __restrict__ idx, const float* __restrict__ gate,
                                              const unsigned char* __restrict__ Ut, const unsigned char* __restrict__ Vt, const float* __restrict__ SU, const float* __restrict__ SV,
                                              float* __restrict__ x, const float* __restrict__ gnext, bf16_t* __restrict__ XBout, int gw, int nw, int lane__, bool dry) {
    const int lane = lane__;
    for (int t0 = gw; t0 < T_TOK; t0 += nw) {
        int lane_ = lane; asm volatile("" : "+v"(lane_));
        const int lane = lane_, lp = lane & 31, hf = lane >> 5;
        const int myslot = ((lane >> 4) & 1) * 2 + ((lane >> 3) & 1);
        const int t = __builtin_amdgcn_readfirstlane(t0);
        float xf[32];
        { const bf16_t* xp = XB + (size_t)t * DM + lp * 32;
#pragma unroll
          for (int i = 0; i < 4; ++i) { const u32x4 r = *(const u32x4*)(xp + 8 * i);
              xf[8 * i] = bf_lo(r.x); xf[8 * i + 1] = bf_hi(r.x); xf[8 * i + 2] = bf_lo(r.y); xf[8 * i + 3] = bf_hi(r.y);
              xf[8 * i + 4] = bf_lo(r.z); xf[8 * i + 5] = bf_hi(r.z); xf[8 * i + 6] = bf_lo(r.w); xf[8 * i + 7] = bf_hi(r.w); } }
        const float rs = rsqrtf(sumsq[t] * (1.0f / DM) + 1e-6f);
        float y[32];
#pragma unroll
        for (int i = 0; i < 32; ++i) y[i] = 0.f;
#pragma unroll 1
        for (int grp = 0; grp < 16; ++grp) {
            const int* ip = idx + (size_t)t * 128 + grp * 8;
            u32x4 u4[4], v4[4]; u32x2 u2[4], v2[4];
#pragma unroll
            for (int k = 0; k < 4; ++k) { const int e = ip[2 * k + hf]; const unsigned char* ur = Ut + (size_t)e * ROW6; u4[k] = *(const u32x4*)(ur + 16 * lp); u2[k] = *(const u32x2*)(ur + 512 + 8 * lp); }
#pragma unroll
            for (int k = 0; k < 4; ++k) { const int e = ip[2 * k + hf]; const unsigned char* vr = Vt + (size_t)e * ROW6; v4[k] = *(const u32x4*)(vr + 16 * lp); v2[k] = *(const u32x2*)(vr + 512 + 8 * lp); }
            const int mypick = 2 * myslot + hf; const int emy = ip[mypick];
            const float wsc = gate[(size_t)t * 128 + grp * 8 + mypick] * SV[emy], usc = SU[emy] * rs;
            float d[4];
#pragma unroll
            for (int k = 0; k < 4; ++k) {
                const v6i w = {(int)u4[k].x, (int)u4[k].y, (int)u4[k].z, (int)u4[k].w, (int)u2[k].x, (int)u2[k].y};
                const v32f r = __builtin_amdgcn_cvt_scalef32_pk32_f32_fp6(w, 1.0f);
                float s0 = 0.f, s1 = 0.f, s2 = 0.f, s3 = 0.f;
#pragma unroll
                for (int i = 0; i < 8; ++i) { s0 += r[4 * i] * xf[4 * i]; s1 += r[4 * i + 1] * xf[4 * i + 1]; s2 += r[4 * i + 2] * xf[4 * i + 2]; s3 += r[4 * i + 3] * xf[4 * i + 3]; }
                d[k] = (s0 + s1) + (s2 + s3);
            }
            float r2[2], r1;
            { const bool hi = (lane & 16) != 0;
#pragma unroll
              for (int i = 0; i < 2; ++i) { const float keep = hi ? d[i + 2] : d[i], send = hi ? d[i] : d[i + 2]; r2[i] = keep + __shfl_xor(send, 16); } }
            { const bool hi = (lane & 8) != 0; const float keep = hi ? r2[1] : r2[0], send = hi ? r2[0] : r2[1]; r1 = keep + __shfl_xor(send, 8); }
            r1 += __shfl_xor(r1, 4); r1 += __shfl_xor(r1, 2); r1 += __shfl_xor(r1, 1);
            const float wgt = wsc * gelu_t(r1 * usc);
#pragma unroll
            for (int k = 0; k < 4; ++k) {
                const int sl = ((k >> 1) & 1) * 16 + (k & 1) * 8;
                const float wlo = __uint_as_float(__builtin_amdgcn_readlane(__float_as_uint(wgt), sl)), whi = __uint_as_float(__builtin_amdgcn_readlane(__float_as_uint(wgt), 32 + sl));
                const float wk = hf ? whi : wlo;
                const v6i w = {(int)v4[k].x, (int)v4[k].y, (int)v4[k].z, (int)v4[k].w, (int)v2[k].x, (int)v2[k].y};
                const v32f r = __builtin_amdgcn_cvt_scalef32_pk32_f32_fp6(w, 1.0f);
#pragma unroll
                for (int i = 0; i < 32; ++i) y[i] += wk * r[i];
            }
        }
        float yo[16];
#pragma unroll
        for (int i = 0; i < 16; ++i) { const float mine = hf ? y[16 + i] : y[i], other = hf ? y[i] : y[16 + i]; yo[i] = mine + __shfl_xor(other, 32); }
        if (dry) continue;
        float* xr = x + (size_t)t * DM + lp * 32 + hf * 16; float ss = 0.f; f32x4 xn[4];
#pragma unroll
        for (int i = 0; i < 4; ++i) { const f32x4 xv = *(const f32x4*)(xr + 4 * i); xn[i] = xv + (f32x4){yo[4 * i], yo[4 * i + 1], yo[4 * i + 2], yo[4 * i + 3]};
            ss += (xn[i][0] * xn[i][0] + xn[i][1] * xn[i][1]) + (xn[i][2] * xn[i][2] + xn[i][3] * xn[i][3]); }
        ss = wave_sum(ss); const float rn = rsqrtf(ss * (1.0f / DM) + 1e-6f);
        const float* gp = gnext + lp * 32 + hf * 16;
        if (MODE == 0) {
            u32x4 o[2];
#pragma unroll
            for (int i = 0; i < 4; ++i) { *(f32x4*)(xr + 4 * i) = xn[i]; const f32x4 gv = *(const f32x4*)(gp + 4 * i); const f32x4 r = xn[i] * gv * rn;
                const unsigned a = cvt_pk_bf16(r[0], r[1]), b = cvt_pk_bf16(r[2], r[3]);
                if ((i & 1) == 0) { o[i >> 1].x = a; o[i >> 1].y = b; } else { o[i >> 1].z = a; o[i >> 1].w = b; } }
            bf16_t* xo = XBout + (size_t)t * DM + lp * 32 + hf * 16;
            *(u32x4*)xo = o[0]; *(u32x4*)(xo + 8) = o[1];
        } else {
#pragma unroll
            for (int i = 0; i < 4; ++i) { const f32x4 gv = *(const f32x4*)(gp + 4 * i); *(f32x4*)(xr + 4 * i) = xn[i] * gv * rn; }
        }
    }
}
#define EXP_RING_BYTES 18432
__device__ __forceinline__ int laneid_opaque() { int z = 0; asm volatile("" : "+v"(z)); return (int)__builtin_amdgcn_mbcnt_hi(~0u, __builtin_amdgcn_mbcnt_lo(~0u, (unsigned)z)); }
typedef unsigned v16u __attribute__((ext_vector_type(16)));
typedef __bf16 v32bf __attribute__((ext_vector_type(32)));
typedef _Float16 v32h __attribute__((ext_vector_type(32)));
typedef _Float16 h2 __attribute__((ext_vector_type(2)));
template <int MODE>
__device__ __forceinline__ void phase_expert6d(const bf16_t* __restrict__ XB, const float* __restrict__ sumsq, const int* __restrict__ idx, const float* __restrict__ gate,
                                               const unsigned char* __restrict__ Ut, const unsigned char* __restrict__ Vt, const float* __restrict__ SU, const float* __restrict__ SV,
                                               float* __restrict__ x, const float* __restrict__ gnext, bf16_t* __restrict__ XBout, unsigned char* smem, int nblk, bool dry, int emode) {
    const int wid = __builtin_amdgcn_readfirstlane(threadIdx.x >> 6), gw = blockIdx.x * 8 + wid, nw = nblk * 8;
    LAS unsigned char* RB = (LAS unsigned char*)smem + wid * EXP_RING_BYTES;
    for (int pr = gw; pr < T_TOK / 2; pr += nw) {
        const int lane = laneid_opaque(), lp = lane & 31, hf = lane >> 5;
        const int myslot = ((lane >> 4) & 1) * 2 + ((lane >> 3) & 1);
        const int t = 2 * pr + hf;
        unsigned key[4];
#pragma unroll
        for (int q = 0; q < 4; ++q) { const int pk = 32 * q + lp; key[q] = ((unsigned)idx[(size_t)t * 128 + pk] << 7) | (unsigned)pk; }
        unsigned xq[16];
        { const bf16_t* xp = XB + (size_t)t * DM + lp * 32;
#pragma unroll
          for (int i = 0; i < 4; ++i) { const u32x4 r = *(const u32x4*)(xp + 8 * i); xq[4 * i] = r.x; xq[4 * i + 1] = r.y; xq[4 * i + 2] = r.z; xq[4 * i + 3] = r.w; } }
        const float rs = rsqrtf(sumsq[t] * (1.0f / DM) + 1e-6f);
#pragma unroll
        for (int k = 2; k <= 128; k <<= 1)
#pragma unroll
            for (int j = k >> 1; j >= 1; j >>= 1) {
                if (j >= 32) {
                    const int dq = j >> 5;
#pragma unroll
                    for (int q = 0; q < 4; ++q) if ((q & dq) == 0) {
                        const bool asc = k == 128 ? true : (((32 * q) & k) == 0);
                        const unsigned lo = min(key[q], key[q | dq]), hi = max(key[q], key[q | dq]);
                        key[q] = asc ? lo : hi; key[q | dq] = asc ? hi : lo;
                    }
                } else {
#pragma unroll
                    for (int q = 0; q < 4; ++q) {
                        const unsigned other = (unsigned)__shfl_xor((int)key[q], j);
                        const int s = 32 * q + lp; const bool asc = (s & k) == 0, lower = (lp & j) == 0;
                        const unsigned lo = min(key[q], other), hi = max(key[q], other);
                        key[q] = (asc == lower) ? lo : hi;
                    }
                }
            }
        int ide[4];
        LAS unsigned* MT = (LAS unsigned*)((LAS unsigned char*)smem + 8 * EXP_RING_BYTES + wid * 1024) + hf * 128;
#pragma unroll
        for (int q = 0; q < 4; ++q) { ide[q] = (int)(key[q] >> 7); const int pk = (int)(key[q] & 127u);
            MT[32 * q + lp] = cvt_pk_bf16(SU[ide[q]] * rs, gate[(size_t)t * 128 + pk] * SV[ide[q]]); }
        h2 yh[16];
#pragma unroll
        for (int i = 0; i < 16; ++i) yh[i] = (h2){(_Float16)0.f, (_Float16)0.f};
        asm volatile("s_waitcnt vmcnt(0)" ::: "memory");
        int pl_[6], po_[6];
#pragma unroll
        for (int _i = 0; _i < 6; ++_i) { const int _byte = 1024 * _i + 16 * lane, _r = (_byte * 683) >> 19; po_[_i] = _byte - 768 * _r; pl_[_i] = 32 * (_r & 1) + (_r >> 1); }
        int ido[4];
#pragma unroll
        for (int q = 0; q < 4; ++q) ido[q] = ide[q] * ROW6;
#define EXP_ADDR(A, HG) do { const int _g = (HG) >> 1; const int _idr = (_g < 8) ? ido[0] : ((_g < 16) ? ido[1] : ((_g < 24) ? ido[2] : ido[3])); \
            _Pragma("unroll") for (int _i = 0; _i < 6; ++_i) A[_i] = __shfl(_idr, (pl_[_i] & 32) + ((4 * _g + pl_[_i]) & 31)) + po_[_i]; } while (0)
#define EXP_DMA(A, HG) do { const int _hg = (HG); const unsigned char* _tab = (_hg & 1) ? Vt : Ut; LAS unsigned char* _dst = RB + (_hg % 3) * 6144; \
            _Pragma("unroll") for (int _i = 0; _i < 6; ++_i) __builtin_amdgcn_global_load_lds((const unsigned*)(_tab + (unsigned)A[_i]), (LAS unsigned*)(_dst + 1024 * _i), 16, 0, 0); } while (0)
#define EXP_ISSUE(HG) do { int _a[6]; EXP_ADDR(_a, HG); EXP_DMA(_a, HG); } while (0)
        { int a0_[6], a1_[6]; EXP_ADDR(a0_, 0); EXP_ADDR(a1_, 1); EXP_DMA(a0_, 0); EXP_DMA(a1_, 1); }
#pragma unroll 1
        for (int g = 0; g < 32; ++g) {
            if (g < 31) { EXP_ISSUE(2 * g + 2); asm volatile("s_waitcnt vmcnt(12)" ::: "memory"); } else { asm volatile("s_waitcnt vmcnt(6)" ::: "memory"); }
            float wgt;
            {
                const LAS unsigned char* bu = RB + ((2 * g) % 3) * 6144 + hf * 768 + 16 * lp;
                float d[4] = {0.f, 0.f, 0.f, 0.f};
                if (emode < 2)
#pragma unroll
                for (int k = 0; k < 4; ++k) {
                    const u32x4 q4 = *(const LAS u32x4*)(bu + k * 1536); const u32x2 q2 = *(const LAS u32x2*)(bu + k * 1536 + 512 - 8 * lp);
                    const v6i w = {(int)q4.x, (int)q4.y, (int)q4.z, (int)q4.w, (int)q2.x, (int)q2.y};
                    const v16u r = __builtin_bit_cast(v16u, __builtin_amdgcn_cvt_scalef32_pk32_bf16_fp6(w, 1.0f));
                    float s0 = 0.f, s1 = 0.f, s2 = 0.f, s3 = 0.f;
#pragma unroll
                    for (int i = 0; i < 4; ++i) { s0 = dot2bf(r[4 * i], xq[4 * i], s0); s1 = dot2bf(r[4 * i + 1], xq[4 * i + 1], s1); s2 = dot2bf(r[4 * i + 2], xq[4 * i + 2], s2); s3 = dot2bf(r[4 * i + 3], xq[4 * i + 3], s3); }
                    d[k] = (s0 + s1) + (s2 + s3);
                }
                float r2[2], r1;
#pragma unroll
                for (int i = 0; i < 2; ++i) { const auto sw = __builtin_amdgcn_permlane16_swap(__float_as_uint(d[i]), __float_as_uint(d[i + 2]), false, false); r2[i] = __uint_as_float(sw[0]) + __uint_as_float(sw[1]); }
                { const bool hi = (lane & 8) != 0; const float keep = hi ? r2[1] : r2[0], send = hi ? r2[0] : r2[1];
                  r1 = keep + __uint_as_float((unsigned)__builtin_amdgcn_update_dpp(0, (int)__float_as_uint(send), 0x128  , 0xf, 0xf, true)); }
                r1 += __uint_as_float((unsigned)__builtin_amdgcn_update_dpp(0, (int)__float_as_uint(r1), 0x141  , 0xf, 0xf, true));
                r1 += __uint_as_float((unsigned)__builtin_amdgcn_update_dpp(0, (int)__float_as_uint(r1), 0x4E  , 0xf, 0xf, true));
                r1 += __uint_as_float((unsigned)__builtin_amdgcn_update_dpp(0, (int)__float_as_uint(r1), 0xB1  , 0xf, 0xf, true));
                const unsigned mt = MT[4 * g + myslot];
                wgt = bf_hi(mt) * gelu_t(r1 * bf_lo(mt));
            }
            if (g < 31) { EXP_ISSUE(2 * g + 3); asm volatile("s_waitcnt vmcnt(12)" ::: "memory"); } else { asm volatile("s_waitcnt vmcnt(0)" ::: "memory"); }
            {
                const LAS unsigned char* bv = RB + ((2 * g + 1) % 3) * 6144 + hf * 768 + 16 * lp;
                if (emode < 1)
#pragma unroll
                for (int k = 0; k < 4; ++k) {
                    const int sl = ((k >> 1) & 1) * 16 + (k & 1) * 8;
                    const float wlo = __uint_as_float(__builtin_amdgcn_readlane(__float_as_uint(wgt), sl)), whi = __uint_as_float(__builtin_amdgcn_readlane(__float_as_uint(wgt), 32 + sl));
                    const float wk = hf ? whi : wlo;
                    const u32x4 q4 = *(const LAS u32x4*)(bv + k * 1536); const u32x2 q2 = *(const LAS u32x2*)(bv + k * 1536 + 512 - 8 * lp);
                    const v6i w = {(int)q4.x, (int)q4.y, (int)q4.z, (int)q4.w, (int)q2.x, (int)q2.y};
                    const v32h r = __builtin_amdgcn_cvt_scalef32_pk32_f16_fp6(w, 1.0f);
                    const h2 w2 = (h2){(_Float16)wk, (_Float16)wk};
#pragma unroll
                    for (int i = 0; i < 16; ++i) yh[i] = __builtin_elementwise_fma((h2){r[2 * i], r[2 * i + 1]}, w2, yh[i]);
                }
            }
        }
#undef EXP_ISSUE
#undef EXP_ADDR
#undef EXP_DMA
        if (dry) continue;
        float y[32];
#pragma unroll
        for (int i = 0; i < 16; ++i) { y[2 * i] = (float)yh[i].x; y[2 * i + 1] = (float)yh[i].y; }
        float* xr = x + (size_t)t * DM + lp * 32; float ss = 0.f;
#pragma unroll
        for (int i = 0; i < 8; ++i) { y[4 * i] += bf_lo(xq[2 * i]); y[4 * i + 1] += bf_hi(xq[2 * i]); y[4 * i + 2] += bf_lo(xq[2 * i + 1]); y[4 * i + 3] += bf_hi(xq[2 * i + 1]);
            ss += (y[4 * i] * y[4 * i] + y[4 * i + 1] * y[4 * i + 1]) + (y[4 * i + 2] * y[4 * i + 2] + y[4 * i + 3] * y[4 * i + 3]); }
        const float* gp = gnext + lp * 32;
        f32x4 gq[8];
#pragma unroll
        for (int i = 0; i < 8; ++i) gq[i] = *(const f32x4*)(gp + 4 * i);
#pragma unroll
        for (int o = 16; o > 0; o >>= 1) ss += __shfl_xor(ss, o);
        const float rn = rsqrtf(ss * (1.0f / DM) + 1e-6f);
        if (MODE == 0) {
            bf16_t* xo = XBout + (((size_t)(t >> 11) * 64 + 2 * lp) * SEQ + (t & 2047)) * 16;
#pragma unroll
            for (int i = 0; i < 4; ++i) {
                { u32x4 xr16; xr16.x = cvt_pk_bf16(y[8 * i], y[8 * i + 1]); xr16.y = cvt_pk_bf16(y[8 * i + 2], y[8 * i + 3]); xr16.z = cvt_pk_bf16(y[8 * i + 4], y[8 * i + 5]); xr16.w = cvt_pk_bf16(y[8 * i + 6], y[8 * i + 7]);
                  *(u32x4*)((bf16_t*)x + (size_t)t * DM + lp * 32 + 8 * i) = xr16; }
                const f32x4 g0 = gq[2 * i], g1 = gq[2 * i + 1];
                u32x4 o; o.x = cvt_pk_bf16(y[8 * i] * g0[0] * rn, y[8 * i + 1] * g0[1] * rn); o.y = cvt_pk_bf16(y[8 * i + 2] * g0[2] * rn, y[8 * i + 3] * g0[3] * rn);
                o.z = cvt_pk_bf16(y[8 * i + 4] * g1[0] * rn, y[8 * i + 5] * g1[1] * rn); o.w = cvt_pk_bf16(y[8 * i + 6] * g1[2] * rn, y[8 * i + 7] * g1[3] * rn);
                *(u32x4*)(xo + (size_t)(i >> 1) * (SEQ * 16) + 8 * (i & 1)) = o;
            }
        } else {
#pragma unroll
            for (int i = 0; i < 8; ++i) { const f32x4 gv = gq[i]; *(f32x4*)(xr + 4 * i) = (f32x4){y[4 * i] * gv[0] * rn, y[4 * i + 1] * gv[1] * rn, y[4 * i + 2] * gv[2] * rn, y[4 * i + 3] * gv[3] * rn}; }
        }
    }
}
typedef const __attribute__((address_space(4))) P* PK;
#define LDS_XST (147456 + 8192)
#define LDS_TOTAL (147456 + 8192 + 16)
__global__ void __launch_bounds__(512) mega(P p_) {
#if defined(__HIP_DEVICE_COMPILE__)
    extern __shared__ __attribute__((aligned(16))) unsigned char smem[];
    cg::grid_group grid = cg::this_grid();
    const int ph_lo = p_.ph_lo, ph_hi = p_.ph_hi;
    volatile LAS unsigned* xst = (volatile LAS unsigned*)(smem + LDS_XST);
    if (threadIdx.x == 0) { xst[0] = 0u; xst[1] = 0u; }
    __syncthreads();
    const XcdBarrier xb = xcd_barrier_post((unsigned*)(p_.ws + WS_BAR), xst);
    const int rep_ph = p_.rep_ph, rep_n = p_.rep_n;
#ifndef PROBE_REPLAY_K
#define PROBE_REPLAY_K -1
#endif
    for (int pass = 0; pass < (PROBE_REPLAY_K >= 0 ? 2 : 1); ++pass)
    for (int ph = ph_lo; ph <= (pass == 0 ? ph_hi : PROBE_REPLAY_K); ++ph) {
        if (ph == 5 || ph == 10) continue;
#if PROBE_REP_N > 1
        const int reps = (ph == rep_ph && rep_n > 1) ? rep_n : 1;
        for (int rep = 0; rep < reps; ++rep) {
        const bool dry = rep > 0;
#else
        {
        const bool dry = PROBE_REPLAY_K >= 0 ? (pass > 0) : false;
#endif
        const int ph_outer = ph; int ph = ph_outer; asm volatile("" : "+s"(ph));
        PK pk = (PK)__builtin_amdgcn_kernarg_segment_ptr(); asm volatile("" : "+s"(pk));
        const P p = *pk;
        unsigned char* ws = p.ws;
        bf16_t* XB = (bf16_t*)(ws + WS_XB);
        int nb_ = gridDim.x; asm volatile("" : "+s"(nb_));
#define PH_IDS int tid_ = threadIdx.x; asm volatile("" : "+v"(tid_)); const int tid = tid_, lane = tid & 63, gw = blockIdx.x * 8 + (tid >> 6), nw = nb_ * 8, gtid = blockIdx.x * 512 + tid, nthr = nb_ * 512; (void)lane; (void)gw; (void)nw; (void)gtid; (void)nthr;
        if (ph == 0) { PH_IDS
            const int pm0 = dry ? PROBE_S5_MODE : 0;
            int s5f_ = (int)((blockIdx.x >> 3) & 1); asm volatile("" : "+s"(s5f_));
            if (s5f_ != 0 && (pm0 == 0 || pm0 == 3))
            pro_s5(p.lam_re, p.lam_im, p.b_re, p.b_im, p.c_re, p.c_im, p.log_step, (bf16_t*)(ws + WS_KTAB), (bf16_t*)(ws + WS_ME), (bf16_t*)(ws + WS_MY), (float*)(ws + WS_LAM64), smem, tid);
            if (s5f_ != 0 && pm0 == 0) pro_wqk(p.wq, p.subkeys, p.norm_ffn_g, (bf16_t*)(ws + WS_WQK), gw, nw, lane);
            if (pm0 == 0) {
                const int wv = tid >> 6, nblk_ = nb_;
                if (wv < 4) {
                    const int rgw = blockIdx.x * 4 + wv, rnw = nblk_ * 4;
                    for (int l = 0; l < 2; ++l) {
                        pro_table6(p.pu + (size_t)l * 16384 * 1024, p.norm_ffn_g + l * DM, ws + WS_UTAB + MB(12) * l, (float*)(ws + WS_SU) + l * 16384, rgw, rnw, lane);
                        pro_table6(p.pv + (size_t)l * 16384 * 1024, nullptr, ws + WS_VTAB + MB(12) * l, (float*)(ws + WS_SV) + l * 16384, rgw, rnw, lane);
                    }
                } else if (wv < 7) {
                    pro_rmsnorm_rows(p.x, p.norm_mix_g, XB, blockIdx.x * 3 + (wv - 4), nblk_ * 3, lane);
                } else {
                    const int rt = blockIdx.x * 64 + lane, rn = nblk_ * 64;
                    pro_transpose<true>(p.w_in, 2560, nullptr, (bf16_t*)(ws + WS_WTIN), rt, rn);
                    pro_transpose<false>(p.w_out, 1024, nullptr, (bf16_t*)(ws + WS_WTOUT), rt, rn);
                    pro_transpose<false>(p.glu_w, 1024, nullptr, (bf16_t*)(ws + WS_WTGLU), rt, rn);
                }
                if (s5f_ == 0) pro_wqk(p.wq, p.subkeys, p.norm_ffn_g, (bf16_t*)(ws + WS_WQK), gw, nw, lane);
            }
            if (pm0 == 1) {
            pro_rmsnorm_rows(p.x, p.norm_mix_g, XB, gw, nw, lane);
            pro_transpose<true>(p.w_in, 2560, nullptr, (bf16_t*)(ws + WS_WTIN), gtid, nthr);
            pro_transpose<false>(p.w_out, 1024, nullptr, (bf16_t*)(ws + WS_WTOUT), gtid, nthr);
            pro_wqk(p.wq, p.subkeys, p.norm_ffn_g, (bf16_t*)(ws + WS_WQK), gw, nw, lane);
            pro_transpose<false>(p.glu_w, 1024, nullptr, (bf16_t*)(ws + WS_WTGLU), gtid, nthr);
            }
            if (pm0 == 2)
            for (int l = 0; l < 2; ++l) {
                pro_table6(p.pu + (size_t)l * 16384 * 1024, p.norm_ffn_g + l * DM, ws + WS_UTAB + MB(12) * l, (float*)(ws + WS_SU) + l * 16384, gw, nw, lane);
                pro_table6(p.pv + (size_t)l * 16384 * 1024, nullptr, ws + WS_VTAB + MB(12) * l, (float*)(ws + WS_SV) + l * 16384, gw, nw, lane);
            }
            if (s5f_ == 0 && (pm0 == 0 || pm0 == 3))
            pro_s5(p.lam_re, p.lam_im, p.b_re, p.b_im, p.c_re, p.c_im, p.log_step, (bf16_t*)(ws + WS_KTAB), (bf16_t*)(ws + WS_ME), (bf16_t*)(ws + WS_MY), (float*)(ws + WS_LAM64), smem, tid);
            if (pm0 != 0) {
            } else {
            float* ssa = (float*)(ws + WS_SSA);
            for (int i = gtid; i < 2 * T_TOK; i += nthr) ssa[i] = 0.f;
            }
        } else if (ph == 1) {
            EpiIn e{(bf16_t*)(ws + WS_Q), (bf16_t*)(ws + WS_K), (bf16_t*)(ws + WS_VT), (bf16_t*)(ws + WS_UG), (bf16_t*)(ws + WS_GG)};
            pg8::Gemm g{XB, (const bf16_t*)(ws + WS_WTIN), T_TOK, 2560, 1024}; pg8::StaticOrder S; S.init(T_TOK, 2560, gridDim.x, blockIdx.x);
            pg8::gemm_phase<EpiIn, pg8::StaticOrder, true, true>((PG8_LAS unsigned char*)smem, g, S, e);
        } else if (ph == 2) { PH_IDS
            const int gwx = (nb_ & 7) ? gw : (((int)(blockIdx.x & 7) * (nb_ >> 3) + (int)(blockIdx.x >> 3)) * 8 + (tid >> 6));
            for (int r2 = 0; r2 < ((p.rep_ph == 20 && p.rep_n > 1) ? p.rep_n : 1); ++r2)
                phase_attn((const bf16_t*)(ws + WS_Q), (const bf16_t*)(ws + WS_K), (const bf16_t*)(ws + WS_VT), (bf16_t*)(ws + WS_MIXB), gwx, nw, lane, (PROBE_REP_N > 1 && p.rep_ph == 20 && r2 + 1 < p.rep_n) ? PROBE_S5_MODE : 0);
            for (int r2 = 0; r2 < ((p.rep_ph == 21 && p.rep_n > 1) ? p.rep_n : 1); ++r2)
                phase_sgu((const bf16_t*)(ws + WS_UG), (const bf16_t*)(ws + WS_GG), p.sgu_norm_g, p.sgu_w, p.sgu_b, (bf16_t*)(ws + WS_MIXB), smem);
        } else if (ph == 3) {
            EpiRes e{p.x, p.out, XB, (float*)(ws + WS_SSA), dry};
            pg8::Gemm g{(const bf16_t*)(ws + WS_MIXB), (const bf16_t*)(ws + WS_WTOUT), T_TOK, 1024, 1024}; pg8::StaticOrder S; S.init(T_TOK, 1024, gridDim.x, blockIdx.x);
            pg8::gemm_phase<EpiRes, pg8::StaticOrder, true, true>((PG8_LAS unsigned char*)smem, g, S, e);
        }
        else if (ph == 4 || ph == 9) {
            const int l = ph == 4 ? 0 : 1;
            EpiScores e{(const float*)(ws + (l ? WS_SSB : WS_SSA)), (unsigned short*)(ws + WS_SCORES)};
            pg8::Gemm g{XB, (const bf16_t*)(ws + WS_WQK) + (size_t)l * 2048 * 1024, T_TOK, 2048, 1024}; pg8::StaticOrder S; S.init(T_TOK, 2048, gridDim.x, blockIdx.x);
            pg8::gemm_phase<EpiScores, pg8::StaticOrder, true, true>((PG8_LAS unsigned char*)smem, g, S, e);
            if (!(dry && PROBE_S5_MODE == 9))
                phase_topk_own((const unsigned short*)(ws + WS_SCORES), (const float*)(ws + (l ? WS_SSB : WS_SSA)), (int*)(ws + WS_IDX), (float*)(ws + WS_GATE), smem, S);
        } else if (ph == 6) {
            phase_expert6d<0>(XB, (const float*)(ws + WS_SSA), (const int*)(ws + WS_IDX), (const float*)(ws + WS_GATE), ws + WS_UTAB, ws + WS_VTAB, (const float*)(ws + WS_SU), (const float*)(ws + WS_SV),
                            p.out, p.norm_mix_g + DM, (bf16_t*)(ws + WS_BIG + MB(64)), smem, nb_, dry, dry ? PROBE_S5_MODE : 0);
        }
        else if (ph == 7) {
            phase_s5((const bf16_t*)(ws + WS_BIG + MB(64)), (const bf16_t*)(ws + WS_KTAB), (const bf16_t*)(ws + WS_ME), (const bf16_t*)(ws + WS_MY), (const float*)(ws + WS_LAM64), p.s5_d, (bf16_t*)(ws + WS_GBUF), smem, dry ? PROBE_S5_MODE : 0);
        } else if (ph == 8) {
            EpiGlu e{(const bf16_t*)(ws + WS_GBUF), p.glu_b, p.out, XB, (float*)(ws + WS_SSB), dry};
            pg8::Gemm g{(const bf16_t*)(ws + WS_GBUF), (const bf16_t*)(ws + WS_WTGLU), T_TOK, 1024, 1024}; pg8::StaticOrder S; S.init(T_TOK, 1024, gridDim.x, blockIdx.x);
            pg8::gemm_phase<EpiGlu, pg8::StaticOrder, true, true>((PG8_LAS unsigned char*)smem, g, S, e);
        } else if (ph == 11) {
            phase_expert6d<1>(XB, (const float*)(ws + WS_SSB), (const int*)(ws + WS_IDX), (const float*)(ws + WS_GATE), ws + WS_UTAB + MB(12), ws + WS_VTAB + MB(12), (const float*)(ws + WS_SU) + 16384, (const float*)(ws + WS_SV) + 16384,
                            p.out, p.final_g, XB, smem, nb_, dry, dry ? PROBE_S5_MODE : 0);
        }
        }
        if (ph < ph_hi || PROBE_REPLAY_K >= 0) { if (ph_lo < 0) grid.sync(); else xcd_barrier(xb); }
    }
#endif
}

static void fill_params(P& p, void* const* d_in, void* d_out, void* d_ws) {
    const float** f = (const float**)&p;
    for (int i = 0; i < 23; ++i) f[i] = (const float*)d_in[i];
    p.out = (float*)d_out; p.ws = (unsigned char*)d_ws;
}
#define LAST_OPT_PHASE 11
extern "C" void kernel_launch(void* const* d_in, const int* in_sizes, int n_in, void* d_out, int out_size, void* d_ws, size_t ws_size, hipStream_t stream) {
    static int grid = 0;
    if (!grid) {
        int dev = 0, cus = 0, per_cu = 0;
        (void)hipGetDevice(&dev); (void)hipDeviceGetAttribute(&cus, hipDeviceAttributeMultiprocessorCount, dev);
        (void)hipFuncSetAttribute((const void*)mega, hipFuncAttributeMaxDynamicSharedMemorySize, LDS_TOTAL);
        (void)hipOccupancyMaxActiveBlocksPerMultiprocessor(&per_cu, (const void*)mega, 512, LDS_TOTAL);
        if (per_cu < 1) { fprintf(stderr, "kernel_launch: occupancy query reports %d blocks/CU\n", per_cu); per_cu = 1; }
        grid = cus;
        if (ws_size < (size_t)WS_END) fprintf(stderr, "kernel_launch: workspace too small (%zu < %zu)\n", ws_size, (size_t)WS_END);
    }
    P p{}; fill_params(p, d_in, d_out, d_ws);
    p.ph_lo = 0; p.ph_hi = LAST_OPT_PHASE; p.rep_ph = PROBE_REP_PH; p.rep_n = PROBE_REP_N;
    (void)hipMemsetAsync((char*)d_ws + WS_BAR, 0, XCD_BAR_WORDS * sizeof(unsigned), stream);
    void* args[] = {&p};
    hipError_t e = hipLaunchCooperativeKernel((const void*)mega, dim3(grid), dim3(512), args, LDS_TOTAL, stream);
    if (e != hipSuccess) fprintf(stderr, "cooperative launch failed: %s (grid %d)\n", hipGetErrorString(e), grid);
}
```
